# Optimizing an MI355X kernel written in HIP

```python
import math
import jax, jax.numpy as jnp
from jax import lax
import numpy as np

D_MODEL = 4096
BATCH = 4
SEQ = 4096
DEPTH = 4

N_META = 16
D_MIX = D_MODEL
MLA_HEADS = D_MODEL // 256
MLA_NOPE = 128
MLA_ROPE = 64
MLA_V = 128
Q_LORA = D_MODEL // 4
KV_LORA = D_MODEL // 8
SB_HEADS = D_MODEL // 256
SB_HEAD_DIM = 128
W_MLA = MLA_HEADS * MLA_V
W_SB = SB_HEADS * SB_HEAD_DIM
BLOCK_Q = 128
ROPE_THETA = 10000.0
EPS = 1e-6
MLA_SCALE = 1.0 / math.sqrt(MLA_NOPE + MLA_ROPE)
SB_SCALE = 1.0 / math.sqrt(SB_HEAD_DIM)
IN_SIZES = (Q_LORA, KV_LORA, MLA_ROPE, W_MLA, W_SB, W_SB, W_SB, W_SB)
D_IN = Q_LORA + KV_LORA + MLA_ROPE + W_MLA + 4 * W_SB

kernel_name = "hymba_mla_stickbreaking_hybrid"


def rms_norm(x, g):
    xf = x.astype(jnp.float32)
    y = xf * lax.rsqrt(jnp.mean(xf * xf, axis=-1, keepdims=True) + EPS)
    return (y * g.astype(jnp.float32)).astype(x.dtype)


def rope_tables(pos, dtype):
    inv_freq = ROPE_THETA ** (-jnp.arange(0, MLA_ROPE, 2, dtype=jnp.float32) / MLA_ROPE)
    ang = pos.astype(jnp.float32)[:, None] * inv_freq[None, :]
    return jnp.cos(ang).astype(dtype), jnp.sin(ang).astype(dtype)


def apply_rope(x, cos, sin):
    half = x.shape[-1] // 2
    x1, x2 = x[..., :half], x[..., half:]
    return jnp.concatenate([x1 * cos - x2 * sin, x2 * cos + x1 * sin], axis=-1)


def mla_block(q_nope, q_rope, k_nope, k_rope, v, q_pos, k_pos):
    s = (jnp.einsum('bqhd,bkhd->bhqk', q_nope, k_nope, preferred_element_type=jnp.float32)
         + jnp.einsum('bqhr,bkr->bhqk', q_rope, k_rope, preferred_element_type=jnp.float32))
    s = s * MLA_SCALE
    causal = k_pos[None, :] <= q_pos[:, None]
    s = jnp.where(causal, s, -jnp.inf)
    p = jax.nn.softmax(s, axis=-1)
    return jnp.einsum('bhqk,bkhd->bqhd', p.astype(v.dtype), v)


def sb_block(q, k, v, q_pos, k_pos):
    z = jnp.einsum('bqhd,bkhd->bhqk', q, k, preferred_element_type=jnp.float32) * SB_SCALE
    strict = k_pos[None, :] < q_pos[:, None]
    log_beta = jax.nn.log_sigmoid(z)
    log_one_minus = jnp.where(strict, jax.nn.log_sigmoid(-z), 0.0)
    log_remaining = lax.cumsum(log_one_minus, axis=3, reverse=True) - log_one_minus
    a = jnp.where(strict, jnp.exp(log_beta + log_remaining), 0.0)
    return jnp.einsum('bhqk,bkhd->bqhd', a.astype(v.dtype), v)


def blocked_attention(block_fn, qs, kvs, pos):
    B, L = qs[0].shape[0], qs[0].shape[1]
    meta_out = block_fn(*[a[:, :N_META] for a in qs], *[a[:, :N_META] for a in kvs],
                        pos[:N_META], pos[:N_META])
    n_blk = (L - N_META) // BLOCK_Q

    def to_blocks(a):
        r = a[:, N_META:].reshape((B, n_blk, BLOCK_Q) + a.shape[2:])
        return jnp.moveaxis(r, 1, 0)

    q_blocks = tuple(to_blocks(a) for a in qs)
    pos_blocks = pos[N_META:].reshape(n_blk, BLOCK_Q)

    def body(args):
        *qb, pb = args
        return block_fn(*qb, *kvs, pb, pos)

    out = lax.map(body, (*q_blocks, pos_blocks))
    out = jnp.moveaxis(out, 0, 1).reshape((B, L - N_META) + out.shape[3:])
    return jnp.concatenate([meta_out, out], axis=1)


def hybrid_layer(h, g_norm, w_in, g_q, g_kv, w_uq, w_ukv, g_out_mla, g_out_sb, w_o,
                 cos, sin, pos):
    B, L, _ = h.shape
    u = rms_norm(h, g_norm)
    proj = u @ w_in
    split_points = tuple(int(v) for v in np.cumsum(IN_SIZES)[:-1])
    c_q, c_kv, k_r, z_mla, q_sb, k_sb, v_sb, z_sb = jnp.split(proj, split_points, axis=-1)

    q = (rms_norm(c_q, g_q) @ w_uq).reshape(B, L, MLA_HEADS, MLA_NOPE + MLA_ROPE)
    q_nope = q[..., :MLA_NOPE]
    q_rope = apply_rope(q[..., MLA_NOPE:], cos[:, None, :], sin[:, None, :])
    kv = (rms_norm(c_kv, g_kv) @ w_ukv).reshape(B, L, MLA_HEADS, MLA_NOPE + MLA_V)
    k_nope, v_mla = kv[..., :MLA_NOPE], kv[..., MLA_NOPE:]
    k_rope = apply_rope(k_r, cos, sin)
    y_mla = blocked_attention(mla_block, (q_nope, q_rope), (k_nope, k_rope, v_mla), pos)
    y_mla = y_mla.reshape(B, L, W_MLA)

    q_s = q_sb.reshape(B, L, SB_HEADS, SB_HEAD_DIM)
    k_s = k_sb.reshape(B, L, SB_HEADS, SB_HEAD_DIM)
    v_s = v_sb.reshape(B, L, SB_HEADS, SB_HEAD_DIM)
    y_sb = blocked_attention(sb_block, (q_s,), (k_s, v_s), pos).reshape(B, L, W_SB)

    y = jnp.concatenate([rms_norm(y_mla, g_out_mla) * jax.nn.silu(z_mla),
                         rms_norm(y_sb, g_out_sb) * jax.nn.silu(z_sb)], axis=-1)
    return h + y @ w_o


def setup_inputs(seed: int = 0) -> dict:
    key = jax.random.key(seed)
    ks = jax.random.split(key, 13)
    f32 = jnp.float32
    x = jax.random.normal(ks[0], (BATCH, SEQ, D_MODEL), f32)
    meta_tokens = jax.random.normal(ks[1], (N_META, D_MODEL), f32)
    g_norm = 1.0 + 0.02 * jax.random.normal(ks[2], (DEPTH, D_MODEL), f32)
    w_in = jax.random.normal(ks[3], (DEPTH, D_MODEL, D_IN), f32) * D_MODEL ** -0.5
    g_q = 1.0 + 0.02 * jax.random.normal(ks[4], (DEPTH, Q_LORA), f32)
    g_kv = 1.0 + 0.02 * jax.random.normal(ks[5], (DEPTH, KV_LORA), f32)
    w_uq = jax.random.normal(ks[6], (DEPTH, Q_LORA, MLA_HEADS * (MLA_NOPE + MLA_ROPE)), f32) * Q_LORA ** -0.5
    w_ukv = jax.random.normal(ks[7], (DEPTH, KV_LORA, MLA_HEADS * (MLA_NOPE + MLA_V)), f32) * KV_LORA ** -0.5
    g_out_mla = 1.0 + 0.02 * jax.random.normal(ks[8], (DEPTH, W_MLA), f32)
    g_out_sb = 1.0 + 0.02 * jax.random.normal(ks[9], (DEPTH, W_SB), f32)
    w_o = jax.random.normal(ks[10], (DEPTH, D_MIX, D_MODEL), f32) * D_MIX ** -0.5
    g_final = 1.0 + 0.02 * jax.random.normal(ks[11], (D_MODEL,), f32)
    return {"x": x, "meta_tokens": meta_tokens, "g_norm": g_norm, "w_in": w_in,
            "g_q": g_q, "g_kv": g_kv, "w_uq": w_uq, "w_ukv": w_ukv,
            "g_out_mla": g_out_mla, "g_out_sb": g_out_sb, "w_o": w_o,
            "g_final": g_final}


def reference(x, meta_tokens, g_norm, w_in, g_q, g_kv, w_uq, w_ukv, g_out_mla, g_out_sb,
              w_o, g_final):
    B = x.shape[0]
    meta = jnp.broadcast_to(meta_tokens[None].astype(x.dtype), (B, N_META, D_MODEL))
    h = jnp.concatenate([meta, x], axis=1)
    L = h.shape[1]
    pos = jnp.arange(L, dtype=jnp.int32)
    cos, sin = rope_tables(pos, x.dtype)
    for i in range(DEPTH):
        h = hybrid_layer(h, g_norm[i], w_in[i], g_q[i], g_kv[i], w_uq[i], w_ukv[i],
                         g_out_mla[i], g_out_sb[i], w_o[i], cos, sin, pos)
    return rms_norm(h[:, N_META:], g_final)
```

```cpp
#include <hip/hip_runtime.h>
#include <hip/hip_bf16.h>
#include <cstdio>
#include <cstdint>
#include <cmath>
namespace pg8 {
#define PG8_LAS __attribute__((address_space(3)))
typedef unsigned short bf16_t;
typedef short bf16x8 __attribute__((ext_vector_type(8)));
typedef float f32x4 __attribute__((ext_vector_type(4)));
typedef unsigned u32x4 __attribute__((ext_vector_type(4)));
constexpr int BM = 256, BK = 64, HALF = 128, HTB = HALF * BK * 2  , STAGE_BYTES = 8 * HTB, NXCD = 8, WGM = 8;

__host__ __device__ __forceinline__ int lds_byte(int r, int c) { const int st = (r >> 4) * 2 + (c >> 5), rr = r & 15, cc = c & 31, ob = rr * 64 + cc * 2; return st * 1024 + (ob ^ (((ob >> 9) & 1) << 5)); }
__host__ __device__ __forceinline__ void stage_rc(int b, int& R, int& C) { const int st = b / 1024, sb = b % 1024, swz = sb ^ (((sb >> 9) & 1) << 5); R = (st >> 1) * 16 + swz / 64; C = (st & 1) * 32 + (swz % 64) / 2; }
__host__ __device__ __forceinline__ int perm32(int rho) { const int n = rho >> 4, i = rho & 15; return 8 * (i >> 2) + 4 * n + (i & 3); }

struct Unit { int pm, pn, koff; };
struct Gemm { const bf16_t* A; const bf16_t* Bt; int M, N, K, ld; };

struct StaticOrder {
    int nM, nN, nwg, G, c;
    __host__ __device__ void init(int M, int N, int G_, int c_) { nM = M / BM; nN = N / BM; nwg = nM * nN; G = G_; c = c_; }
    __host__ __device__ __forceinline__ bool next(int i, Unit& u) const {
        const long L = (long)i * G + c; if (L >= nwg) return false;
        int wgid = (int)L; { const int q = nwg / NXCD, r = nwg % NXCD, xcd = wgid % NXCD, off = wgid / NXCD; wgid = (xcd < r ? xcd * (q + 1) : r * (q + 1) + (xcd - r) * q) + off; }
        const int nig = WGM * nN, gid = wgid / nig, fm = gid * WGM, gsz = (nM - fm) < WGM ? (nM - fm) : WGM;
        u.pm = fm + ((wgid % nig) % gsz); u.pn = (wgid % nig) / gsz; u.koff = 0; return true;
    }
    __device__ __forceinline__ void a_ready(const Unit&) const {}
    __device__ __forceinline__ void done(const Unit&) const {}
};
struct InAOrder {
    int G, c;
    __host__ __device__ __forceinline__ bool next(int i, Unit& u) const {
        const int L = i * G + c; if (L >= 512) return false;
        const int x = L & 7, j = L >> 3;
        if (x < 7) { u.pm = 8 * x + (j & 7); u.pn = j >> 3; }
        else if (j < 54) { u.pm = 56 + j % 9; u.pn = j / 9; }
        else { const int jj = j - 54; u.pm = 56 + jj % 5; u.pn = 6 + jj / 5; }
        u.koff = 0; return true;
    }
    __device__ __forceinline__ void a_ready(const Unit&) const {}
    __device__ __forceinline__ void done(const Unit&) const {}
};
struct InBOrder {
    int G, c;
    __host__ __device__ __forceinline__ bool next(int i, Unit& u) const {
        constexpr int nM = 65, nN = 39, nwg = nM * nN;
        const int L = i * G + c; if (L >= nwg + 8) return false;
        u.koff = 0;
        if (L >= nwg) { const int k = L - nwg; u.pm = 61 + (k & 3); u.pn = 6 + (k >> 2); return true; }
        int wgid = L; { constexpr int q = nwg / NXCD, r = nwg % NXCD; const int xcd = wgid % NXCD, off = wgid / NXCD; wgid = (xcd < r ? xcd * (q + 1) : r * (q + 1) + (xcd - r) * q) + off; }
        constexpr int nig = WGM * nN; const int gid = wgid / nig, fm = gid * WGM, gsz = (nM - fm) < WGM ? (nM - fm) : WGM;
        u.pm = fm + ((wgid % nig) % gsz); u.pn = 8 + (wgid % nig) / gsz; return true;
    }
    __device__ __forceinline__ void a_ready(const Unit&) const {}
    __device__ __forceinline__ void done(const Unit&) const {}
};
struct SplitKOrder {
    int pm, nN, nS, kslice, G, c;
    __host__ __device__ __forceinline__ bool next(int i, Unit& u) const { const int L = i * G + c; if (L >= nN * nS) return false; u.pm = pm; u.pn = L % nN; u.koff = (L / nN) * kslice; return true; }
    __device__ __forceinline__ void a_ready(const Unit&) const {}
    __device__ __forceinline__ void done(const Unit&) const {}
};

__device__ __forceinline__ unsigned cvt_pk_bf16(float lo, float hi) { unsigned r; asm volatile("v_cvt_pk_bf16_f32 %0, %1, %2" : "=v"(r) : "v"(lo), "v"(hi)); return r; }
typedef float f32x2 __attribute__((ext_vector_type(2)));

constexpr int SEQL = 4112;
__device__ __forceinline__ void st8_bf16(bf16_t* p, f32x4 v0, f32x4 v1) {
    u32x4 w; w.x = cvt_pk_bf16(v0[0], v0[1]); w.y = cvt_pk_bf16(v0[2], v0[3]); w.z = cvt_pk_bf16(v1[0], v1[1]); w.w = cvt_pk_bf16(v1[2], v1[3]);
    *(u32x4*)p = w;
}
__device__ __forceinline__ float bf_lo(unsigned w) { return __builtin_bit_cast(float, w << 16); }
__device__ __forceinline__ float bf_hi(unsigned w) { return __builtin_bit_cast(float, w & 0xffff0000u); }
__device__ __forceinline__ float st8_bf16_ss(bf16_t* p, f32x4 v0, f32x4 v1) {
    u32x4 w; w.x = cvt_pk_bf16(v0[0], v0[1]); w.y = cvt_pk_bf16(v0[2], v0[3]); w.z = cvt_pk_bf16(v1[0], v1[1]); w.w = cvt_pk_bf16(v1[2], v1[3]);
    *(u32x4*)p = w; float ss = 0.f;
#pragma unroll
    for (int e = 0; e < 4; ++e) { const float x = bf_lo(w[e]), y = bf_hi(w[e]); ss += x * x + y * y; }
    return ss;
}
__device__ __forceinline__ void rope8(const float* tab, f32x4 x1a, f32x4 x1b, f32x4 x2a, f32x4 x2b, bf16_t* o1, bf16_t* o2) {
    const f32x4 c0 = *(const f32x4*)tab, c1 = *(const f32x4*)(tab + 4), s0 = *(const f32x4*)(tab + 32), s1 = *(const f32x4*)(tab + 36);
    st8_bf16(o1, x1a * c0 - x2a * s0, x1b * c1 - x2b * s1);
    st8_bf16(o2, x2a * c0 + x1a * s0, x2b * c1 + x1b * s1);
}
struct EpiIn {
    static constexpr bool PERM = true, AFTER_DRAIN = false, MID = false, PRE = true;
    bf16_t* CQN; bf16_t* CKVN; float* SSQQ; float* SSQKV; bf16_t* KR; bf16_t* Z; bf16_t* QSB; bf16_t* KSB; bf16_t* VSB; const float* rope; const float* rstd;
    __device__ __forceinline__ void pre(float (&p)[4], const Unit& u, int wr, int wc, int fr, int fq) const {
        const int row = u.pm * BM + wr * 64 + fr + (fq >> 1) * HALF + (fq & 1) * 32;
        p[0] = rstd[row]; p[1] = rstd[row + 16];
    }
    __device__ __forceinline__ void epi(const f32x4 (&acc)[2][2][4][2], const Unit& u, int wr, int wc, int fr, int fq, const float (&p)[4]) const {
        const int pn = u.pn, row0 = u.pm * BM + wr * 64 + fr, cin = wc * 32 + 8 * fq;
        float rs[2][4];
#pragma unroll
        for (int ai = 0; ai < 2; ++ai)
#pragma unroll
            for (int m = 0; m < 4; ++m) rs[ai][m] = __shfl(p[m & 1], fr + 16 * (2 * ai + (m >> 1)));
        if (pn < 6) {
            bf16_t* base; float* sq; int ldc, col, nsl, sl;
            if (pn < 4) { base = CQN; ldc = 1024; col = pn * 256; sq = SSQQ; nsl = 16; sl = 4 * pn + wc; } else { base = CKVN; ldc = 512; col = (pn - 4) * 256; sq = SSQKV; nsl = 8; sl = 4 * (pn - 4) + wc; }
#pragma unroll
            for (int ai = 0; ai < 2; ++ai)
#pragma unroll
                for (int m = 0; m < 4; ++m) { const int row = row0 + ai * HALF + m * 16; bf16_t* rowp = base + (size_t)row * ldc + col + cin; float ss = 0.f;
#pragma unroll
                    for (int bj = 0; bj < 2; ++bj) ss += st8_bf16_ss(rowp + bj * HALF, acc[ai][bj][m][0] * rs[ai][m], acc[ai][bj][m][1] * rs[ai][m]);
                    ss += __shfl_xor(ss, 16); ss += __shfl_xor(ss, 32);
                    if (fq == 0) sq[(size_t)row * nsl + sl] = ss; }
        } else if (pn == 6) {
            if (wc == 0) {
#pragma unroll
                for (int ai = 0; ai < 2; ++ai)
#pragma unroll
                    for (int m = 0; m < 4; ++m) { const int row = row0 + ai * HALF + m * 16, pos = row % SEQL;
                        bf16_t* o = KR + (size_t)row * 64 + 8 * fq;
                        rope8(rope + pos * 64 + 8 * fq, acc[ai][0][m][0] * rs[ai][m], acc[ai][0][m][1] * rs[ai][m], acc[ai][1][m][0] * rs[ai][m], acc[ai][1][m][1] * rs[ai][m], o, o + 32); }
            }
        } else {
            bf16_t* base; int ldc, col; float qs = 1.f;
            if (pn < 15) { base = Z; ldc = 4096; col = (pn - 7) * 256; }
            else if (pn < 23) { base = QSB; ldc = 2048; col = (pn - 15) * 256; qs = -0.12751743f; }
            else if (pn < 31) { base = KSB; ldc = 2048; col = (pn - 23) * 256; }
            else if (pn < 39) { base = VSB; ldc = 2048; col = (pn - 31) * 256; }
            else { base = Z; ldc = 4096; col = 2048 + (pn - 39) * 256; }
#pragma unroll
            for (int ai = 0; ai < 2; ++ai)
#pragma unroll
                for (int m = 0; m < 4; ++m) { bf16_t* rowp = base + (size_t)(row0 + ai * HALF + m * 16) * ldc + col + cin;
#pragma unroll
                    for (int bj = 0; bj < 2; ++bj) st8_bf16(rowp + bj * HALF, acc[ai][bj][m][0] * (rs[ai][m] * qs), acc[ai][bj][m][1] * (rs[ai][m] * qs)); }
        }
    }
};
struct EpiUq {
    static constexpr bool PERM = true, AFTER_DRAIN = false, MID = false, PRE = true;
    bf16_t* QM; const float* rope; const float* SSQQ;
    __device__ __forceinline__ void pre(float (&p)[4], const Unit& u, int wr, int wc, int fr, int fq) const {
        const int row = u.pm * BM + wr * 64 + fr + (fq >> 1) * HALF + (fq & 1) * 32;
#pragma unroll
        for (int j = 0; j < 2; ++j) { const f32x4* sp = (const f32x4*)(SSQQ + (size_t)(row + 16 * j) * 16); const f32x4 a = sp[0], b = sp[1], c = sp[2], d = sp[3];
            const float s = ((a[0] + a[1]) + (a[2] + a[3])) + ((b[0] + b[1]) + (b[2] + b[3])) + ((c[0] + c[1]) + (c[2] + c[3])) + ((d[0] + d[1]) + (d[2] + d[3]));
            p[j] = 1.0f / sqrtf(s * (1.0f / 1024.0f) + 1e-6f); }
    }
    __device__ __forceinline__ void epi(const f32x4 (&acc)[2][2][4][2], const Unit& u, int wr, int wc, int fr, int fq, const float (&p)[4]) const {
        const int pn = u.pn, row0 = u.pm * BM + wr * 64 + fr, cin = wc * 32 + 8 * fq;
#define RSQ_(ai, m) (__shfl(p[(m) & 1], fr + 16 * (2 * (ai) + ((m) >> 1))) * 0.10411754f)
        if (pn < 8) {
#pragma unroll
            for (int ai = 0; ai < 2; ++ai)
#pragma unroll
                for (int m = 0; m < 4; ++m) { bf16_t* rowp = QM + (size_t)(row0 + ai * HALF + m * 16) * 3072 + cin; const float r_ = RSQ_(ai, m);
#pragma unroll
                    for (int bj = 0; bj < 2; ++bj) st8_bf16(rowp + (2 * pn + bj) * 192, acc[ai][bj][m][0] * r_, acc[ai][bj][m][1] * r_); }
        } else {
            const int head = 4 * (pn - 8) + wc;
#pragma unroll
            for (int ai = 0; ai < 2; ++ai)
#pragma unroll
                for (int m = 0; m < 4; ++m) { const int row = row0 + ai * HALF + m * 16, pos = row % SEQL; const float r_ = RSQ_(ai, m);
                    bf16_t* o = QM + (size_t)row * 3072 + head * 192 + 128 + 8 * fq;
                    rope8(rope + pos * 64 + 8 * fq, acc[ai][0][m][0] * r_, acc[ai][0][m][1] * r_, acc[ai][1][m][0] * r_, acc[ai][1][m][1] * r_, o, o + 32); }
        }
#undef RSQ_
    }
};
struct EpiUkv {
    static constexpr bool PERM = true, AFTER_DRAIN = false, MID = false, PRE = true;
    bf16_t* KM; bf16_t* VM; const float* SSQKV;
    __device__ __forceinline__ void pre(float (&p)[4], const Unit& u, int wr, int wc, int fr, int fq) const {
        const int row = u.pm * BM + wr * 64 + fr + (fq >> 1) * HALF + (fq & 1) * 32;
#pragma unroll
        for (int j = 0; j < 2; ++j) { const f32x4* sp = (const f32x4*)(SSQKV + (size_t)(row + 16 * j) * 8); const f32x4 a = sp[0], b = sp[1];
            const float s = ((a[0] + a[1]) + (a[2] + a[3])) + ((b[0] + b[1]) + (b[2] + b[3]));
            p[j] = 1.0f / sqrtf(s * (1.0f / 512.0f) + 1e-6f); }
    }
    __device__ __forceinline__ void epi(const f32x4 (&acc)[2][2][4][2], const Unit& u, int wr, int wc, int fr, int fq, const float (&p)[4]) const {
        const int pn = u.pn, row0 = u.pm * BM + wr * 64 + fr, cin = wc * 32 + 8 * fq;

        bf16_t* base = pn < 8 ? KM : VM; const int col = (pn & 7) * 256;
#pragma unroll
        for (int ai = 0; ai < 2; ++ai)
#pragma unroll
            for (int m = 0; m < 4; ++m) { bf16_t* rowp = base + (size_t)(row0 + ai * HALF + m * 16) * 2048 + col + cin;
                const float r_ = __shfl(p[m & 1], fr + 16 * (2 * ai + (m >> 1)));
#pragma unroll
                for (int bj = 0; bj < 2; ++bj) st8_bf16(rowp + bj * HALF, acc[ai][bj][m][0] * r_, acc[ai][bj][m][1] * r_); }
    }
};
struct EpiResBf {
    static constexpr bool PERM = true, AFTER_DRAIN = false, MID = true, PRE = false;
    bf16_t* HB; float* SSQ; const PG8_LAS float* tab;
    __device__ __forceinline__ void mid(f32x4 (&acc)[2][2][4][2], const Unit& u, int wr, int wc, int fr, int fq) const {
        const int row0 = wr * 64 + fr; float f[2][4];
#pragma unroll
        for (int ai = 0; ai < 2; ++ai)
#pragma unroll
            for (int m = 0; m < 4; ++m) f[ai][m] = tab[row0 + ai * HALF + m * 16];
#pragma unroll
        for (int ai = 0; ai < 2; ++ai)
#pragma unroll
            for (int bj = 0; bj < 2; ++bj)
#pragma unroll
                for (int m = 0; m < 4; ++m)
#pragma unroll
                    for (int n = 0; n < 2; ++n) acc[ai][bj][m][n] *= f[ai][m];
    }
    __device__ __forceinline__ void operator()(const f32x4 (&acc)[2][2][4][2], const Unit& u, int wr, int wc, int fr, int fq) const {
        const int row0 = u.pm * BM + wr * 64 + fr, col0 = u.pn * BM + wc * 32 + 8 * fq;
#pragma unroll
        for (int ai = 0; ai < 2; ++ai) {
            u32x4 hv[4][2]; float rsbv[4];
#pragma unroll
            for (int m = 0; m < 4; ++m) { rsbv[m] = tab[256 + wr * 64 + fr + ai * HALF + m * 16];
#pragma unroll
                for (int bj = 0; bj < 2; ++bj) hv[m][bj] = *(const u32x4*)(HB + (size_t)(row0 + ai * HALF + m * 16) * 4096 + col0 + bj * HALF); }
#pragma unroll
            for (int m = 0; m < 4; ++m) { const int row = row0 + ai * HALF + m * 16; float ss = 0.f; const float rsb = rsbv[m];
#pragma unroll
                for (int bj = 0; bj < 2; ++bj) { const u32x4 h = hv[m][bj]; const f32x4 a0 = acc[ai][bj][m][0] * rsb, a1 = acc[ai][bj][m][1] * rsb;
                    u32x4 w; w.x = cvt_pk_bf16(bf_lo(h.x) + a0[0], bf_hi(h.x) + a0[1]); w.y = cvt_pk_bf16(bf_lo(h.y) + a0[2], bf_hi(h.y) + a0[3]);
                    w.z = cvt_pk_bf16(bf_lo(h.z) + a1[0], bf_hi(h.z) + a1[1]); w.w = cvt_pk_bf16(bf_lo(h.w) + a1[2], bf_hi(h.w) + a1[3]);
                    *(u32x4*)(HB + (size_t)row * 4096 + col0 + bj * HALF) = w;
#pragma unroll
                    for (int e = 0; e < 4; ++e) { const float x = bf_lo(w[e]), y = bf_hi(w[e]); ss += x * x + y * y; } }
                ss += __shfl_xor(ss, 16); ss += __shfl_xor(ss, 32);
                if (fq == 0) SSQ[(size_t)row * 64 + 4 * u.pn + wc] = ss; }
            asm volatile("" ::: "memory");
        }
    }
};

struct EpiSlab {
    static constexpr bool PERM = false, AFTER_DRAIN = false, MID = false, PRE = false;
    float* slab; int kslice; const PG8_LAS float* tab;
    __device__ __forceinline__ void operator()(const f32x4 (&acc)[2][2][4][2], const Unit& u, int wr, int wc, int fr, int fq) const {
        if (wr != 0) return;
        float* base = slab + (size_t)(u.koff / kslice) * 64 * 4096 + u.pn * BM + wc * 32 + 4 * fq;
#pragma unroll
        for (int m = 0; m < 4; ++m) { float* rowp = base + (size_t)(fr + m * 16) * 4096; const int row = u.pm * BM + fr + m * 16;
            const float sc = u.koff < 2048 ? tab[fr + m * 16] * tab[256 + fr + m * 16] : tab[256 + fr + m * 16];
#pragma unroll
            for (int bj = 0; bj < 2; ++bj)
#pragma unroll
                for (int n = 0; n < 2; ++n) *(f32x4*)(rowp + bj * HALF + n * 16) = acc[0][bj][m][n] * sc; }
    }
};

template <class Epi, class Sched, bool ALIGN_EPI = false, bool SP2 = false>
__device__ __forceinline__ void gemm_phase(PG8_LAS unsigned char* lds, const Gemm g, const Sched& S, const Epi& E) {
    int tid_ = threadIdx.x; asm volatile("" : "+v"(tid_));
    const int tid = tid_, wid = __builtin_amdgcn_readfirstlane(tid >> 6), lane = tid & 63, wr = wid >> 2, wc = wid & 3, fr = lane & 15, fq = lane >> 4;
    const int K = g.K, nt = K / BK, LD = g.ld ? g.ld : g.K;
    unsigned voffA[2], voffB[2];
#pragma unroll
    for (int i = 0; i < 2; ++i) { int R, C; stage_rc(tid * 16 + i * 8192, R, C); const int Rb = Epi::PERM ? ((R & ~31) + perm32(R & 31)) : R;
        voffA[i] = (unsigned)(R * LD + C) * 2u; voffB[i] = (unsigned)(Rb * LD + C) * 2u; }
    const size_t kstep = (size_t)(BK * 2);
    const size_t hstep = (size_t)HALF * LD * 2;
    const size_t tstep = 2 * hstep;
    const unsigned ldsw = (unsigned)wid * 1024u;
    const int aoff = lds_byte(wr * 64 + fr, fq * 8), boff = lds_byte(wc * 32 + fr, fq * 8);
#define PG8_SA(b, h) (((b) * 2 + (h)) * HTB)
#define PG8_SB(b, h) ((4 + (b) * 2 + (h)) * HTB)
#define PG8_STAGE(bufoff, gbase, voff) do { _Pragma("unroll") for (int _i = 0; _i < 2; ++_i) \
        __builtin_amdgcn_global_load_lds((const unsigned*)((const char*)(gbase) + (voff)[_i]), (PG8_LAS unsigned*)(lds + (bufoff) + ldsw + _i * 8192), 16, 0, 0); } while (0)
#define PG8_LDA(dst, b, h) do { _Pragma("unroll") for (int m = 0; m < 4; ++m) _Pragma("unroll") for (int k = 0; k < 2; ++k) dst[m][k] = *(const PG8_LAS bf16x8*)(lds + PG8_SA(b, h) + aoff + m * 2048 + k * 1024); } while (0)
#define PG8_LDB(dst, b, h) do { _Pragma("unroll") for (int n = 0; n < 2; ++n) _Pragma("unroll") for (int k = 0; k < 2; ++k) dst[n][k] = *(const PG8_LAS bf16x8*)(lds + PG8_SB(b, h) + boff + n * 2048 + k * 1024); } while (0)
#define PG8_MMA(ai, bj, At, Bt) do { __builtin_amdgcn_s_setprio(1); _Pragma("unroll") for (int m = 0; m < 4; ++m) _Pragma("unroll") for (int n = 0; n < 2; ++n) _Pragma("unroll") for (int k = 0; k < 2; ++k) \
        acc[ai][bj][m][n] = __builtin_amdgcn_mfma_f32_16x16x32_bf16(Bt[n][k], At[m][k], acc[ai][bj][m][n], 0, 0, 0); __builtin_amdgcn_s_setprio(0); } while (0)
#define PG8_WAIT_V(n) asm volatile("s_waitcnt vmcnt(" #n ")" ::: "memory")
#define PG8_WAIT_L(n) asm volatile("s_waitcnt lgkmcnt(" #n ")" ::: "memory")
#define PG8_BAR __builtin_amdgcn_s_barrier()
#define PG8_SCHED __builtin_amdgcn_sched_barrier(0)
    Unit cur, nxt; int ui = 0; float epre[4];
    if (!S.next(0, cur)) return;
    f32x4 acc[2][2][4][2];
#pragma unroll
    for (int a = 0; a < 2; ++a)
#pragma unroll
        for (int b = 0; b < 2; ++b)
#pragma unroll
            for (int m = 0; m < 4; ++m)
#pragma unroll
                for (int n = 0; n < 2; ++n) acc[a][b][m][n] = (f32x4){0.f, 0.f, 0.f, 0.f};
    bf16x8 At[4][2], B0[2][2], B1[2][2];
    const char* cA = (const char*)g.A + (size_t)cur.pm * tstep + (size_t)cur.koff * 2; const char* cB = (const char*)g.Bt + (size_t)cur.pn * tstep + (size_t)cur.koff * 2;
    S.a_ready(cur);
    if constexpr (SP2) {
        PG8_STAGE(PG8_SB(0, 0), cB, voffB); PG8_STAGE(PG8_SB(0, 1), cB + hstep, voffB); PG8_STAGE(PG8_SA(0, 0), cA, voffA); PG8_STAGE(PG8_SA(0, 1), cA + hstep, voffA);
        if (wr == 1) PG8_BAR;
        PG8_WAIT_V(2); PG8_BAR;
        PG8_STAGE(PG8_SB(1, 0), cB + kstep, voffB); PG8_STAGE(PG8_SA(1, 0), cA + kstep, voffA); PG8_STAGE(PG8_SB(1, 1), cB + hstep + kstep, voffB);
        PG8_WAIT_V(6); PG8_BAR;
    } else {
        PG8_STAGE(PG8_SB(0, 0), cB, voffB); PG8_STAGE(PG8_SA(0, 0), cA, voffA); PG8_STAGE(PG8_SB(0, 1), cB + hstep, voffB); PG8_STAGE(PG8_SA(0, 1), cA + hstep, voffA);
        if (wr == 1) PG8_BAR;
        PG8_WAIT_V(4); PG8_BAR;
        PG8_STAGE(PG8_SB(1, 0), cB + kstep, voffB); PG8_STAGE(PG8_SA(1, 0), cA + kstep, voffA); PG8_STAGE(PG8_SB(1, 1), cB + hstep + kstep, voffB);
        PG8_WAIT_V(6); PG8_BAR;
    }
    for (;;) {
        const bool has_next = S.next(ui + 1, nxt);
        const char* nA = has_next ? (const char*)g.A + (size_t)nxt.pm * tstep + (size_t)nxt.koff * 2 : cA; const char* nB = has_next ? (const char*)g.Bt + (size_t)nxt.pn * tstep + (size_t)nxt.koff * 2 : cB;
        for (int t = 0; t < nt; t += 2) {
            if constexpr (Epi::PRE) { if (t == (nt >> 1) - 2) E.pre(epre, cur, wr, wc, fr, fq); }
            if constexpr (Epi::MID) { if (t == (nt >> 1)) E.mid(acc, cur, wr, wc, fr, fq); }
            const bool last = (t == nt - 2);
            const char* a1 = cA + (size_t)(t + 1) * kstep;
            const char* a2 = last ? nA : cA + (size_t)(t + 2) * kstep; const char* b2 = last ? nB : cB + (size_t)(t + 2) * kstep;
            const char* a3 = a2 + kstep; const char* b3 = b2 + kstep;
            if (last && has_next) S.a_ready(nxt);
            if constexpr (SP2) {
            PG8_LDB(B0, 0, 0); PG8_LDB(B1, 0, 1); PG8_SCHED; PG8_LDA(At, 0, 0); PG8_STAGE(PG8_SA(1, 1), a1 + hstep, voffA);
            PG8_WAIT_V(8); PG8_WAIT_L(0); PG8_BAR; PG8_MMA(0, 0, At, B0); PG8_MMA(0, 1, At, B1); PG8_BAR; PG8_SCHED;
            PG8_LDA(At, 0, 1); PG8_STAGE(PG8_SB(0, 0), b2, voffB); PG8_STAGE(PG8_SB(0, 1), b2 + hstep, voffB); PG8_STAGE(PG8_SA(0, 0), a2, voffA);
            PG8_WAIT_V(8); PG8_WAIT_L(0); PG8_BAR; PG8_MMA(1, 0, At, B0); PG8_MMA(1, 1, At, B1); PG8_BAR; PG8_SCHED;
            PG8_LDB(B0, 1, 0); PG8_LDB(B1, 1, 1); PG8_SCHED; PG8_LDA(At, 1, 0); PG8_STAGE(PG8_SA(0, 1), a2 + hstep, voffA);
            PG8_WAIT_V(8); PG8_WAIT_L(0); PG8_BAR; PG8_MMA(0, 0, At, B0); PG8_MMA(0, 1, At, B1); PG8_BAR; PG8_SCHED;
            PG8_LDA(At, 1, 1); PG8_STAGE(PG8_SB(1, 0), b3, voffB); PG8_STAGE(PG8_SB(1, 1), b3 + hstep, voffB); PG8_STAGE(PG8_SA(1, 0), a3, voffA);
            PG8_WAIT_V(8); PG8_WAIT_L(0); PG8_BAR; PG8_MMA(1, 0, At, B0); PG8_MMA(1, 1, At, B1); PG8_BAR; PG8_SCHED;
            } else {
            PG8_LDB(B0, 0, 0); PG8_SCHED; PG8_LDA(At, 0, 0); PG8_STAGE(PG8_SA(1, 1), a1 + hstep, voffA);
            PG8_WAIT_L(8); PG8_BAR; PG8_WAIT_L(0); PG8_MMA(0, 0, At, B0); PG8_BAR; PG8_SCHED;
            PG8_LDB(B1, 0, 1); PG8_STAGE(PG8_SB(0, 0), b2, voffB);
            PG8_BAR; PG8_WAIT_L(0); PG8_MMA(0, 1, At, B1); PG8_BAR;
            PG8_LDA(At, 0, 1); PG8_STAGE(PG8_SA(0, 0), a2, voffA);
            PG8_BAR; PG8_WAIT_L(0); PG8_MMA(1, 0, At, B0); PG8_BAR; PG8_SCHED;
            PG8_STAGE(PG8_SB(0, 1), b2 + hstep, voffB);
            PG8_WAIT_V(6); PG8_BAR; PG8_MMA(1, 1, At, B1); PG8_BAR;
            PG8_LDB(B0, 1, 0); PG8_SCHED; PG8_LDA(At, 1, 0); PG8_STAGE(PG8_SA(0, 1), a2 + hstep, voffA);
            PG8_WAIT_L(8); PG8_BAR; PG8_WAIT_L(0); PG8_MMA(0, 0, At, B0); PG8_BAR; PG8_SCHED;
            PG8_LDB(B1, 1, 1); PG8_STAGE(PG8_SB(1, 0), b3, voffB);
            PG8_BAR; PG8_WAIT_L(0); PG8_MMA(0, 1, At, B1); PG8_BAR;
            PG8_LDA(At, 1, 1); PG8_STAGE(PG8_SA(1, 0), a3, voffA);
            PG8_BAR; PG8_WAIT_L(0); PG8_MMA(1, 0, At, B0); PG8_BAR; PG8_SCHED;
            PG8_STAGE(PG8_SB(1, 1), b3 + hstep, voffB);
            PG8_WAIT_V(6); PG8_BAR; PG8_MMA(1, 1, At, B1); PG8_BAR;
            }
        }
        if constexpr (ALIGN_EPI) { if (wr == 0) PG8_BAR; }
        if constexpr (!Epi::AFTER_DRAIN) { if constexpr (Epi::PRE) E.epi(acc, cur, wr, wc, fr, fq, epre); else E(acc, cur, wr, wc, fr, fq); S.done(cur); }
        if (!has_next) break;
#pragma unroll
        for (int a = 0; a < 2; ++a)
#pragma unroll
            for (int b = 0; b < 2; ++b)
#pragma unroll
                for (int m = 0; m < 4; ++m)
#pragma unroll
                    for (int n = 0; n < 2; ++n) acc[a][b][m][n] = (f32x4){0.f, 0.f, 0.f, 0.f};
        cur = nxt; cA = nA; cB = nB; ++ui;
        if constexpr (ALIGN_EPI) { if (wr == 1) PG8_BAR; }
    }
    PG8_WAIT_V(0);
    if constexpr (!ALIGN_EPI) { if (wr == 0) PG8_BAR; }
    PG8_BAR;
    if constexpr (Epi::AFTER_DRAIN) { E.fused(acc, cur, wr, wc, fr, fq, lds, wid, lane); S.done(cur); }
#undef PG8_SA
#undef PG8_SB
#undef PG8_STAGE
#undef PG8_LDA
#undef PG8_LDB
#undef PG8_MMA
#undef PG8_WAIT_V
#undef PG8_WAIT_L
#undef PG8_BAR
#undef PG8_SCHED
}
}

namespace att {
typedef unsigned short bf16_t;
typedef short bf16x8 __attribute__((ext_vector_type(8)));
typedef short s16x4 __attribute__((ext_vector_type(4)));
typedef float f32x16 __attribute__((ext_vector_type(16)));
typedef float f32x4 __attribute__((ext_vector_type(4)));
typedef unsigned u32x4 __attribute__((ext_vector_type(4)));
constexpr int NW = 8, QBLK = 32, KVBLK = 64, QB = NW * QBLK;
constexpr int SHM_V = KVBLK * 128 * 2, SHM_KN = KVBLK * 128 * 2, SHM_KR = KVBLK * 64 * 2;
constexpr int OFF_V = 0, OFF_KN = 2 * SHM_V, OFF_KR = OFF_KN + 2 * SHM_KN, OFF_WS = OFF_KR + 2 * SHM_KR, OFF_QR = OFF_WS + NW * 64 * 4, ATT_LDS = OFF_QR + NW * 4096;
constexpr int kn_off(int b) { return b == 2 ? OFF_QR : OFF_KN + b * SHM_KN; }
constexpr int v_off(int b) { return b == 2 ? OFF_KR : OFF_V + b * SHM_V; }
constexpr int LDQM = 3072, LDK = 2048, LDKR = 64, LDV = 2048, LDO = 4096, LDQS = 2048;
constexpr float LOG2E = 1.4426950408889634f;
constexpr float MLA_SCALE = 0.07216878364870323f;
constexpr float SB_SCALE = 0.08838834764831845f;
constexpr unsigned WBIG = 0x40000000u;

#define KSWZ(row, colB) ((row) * 256 + ((colB) ^ (((row) & 15) << 4)))
#define KRSWZ(row, colB) ((row) * 128 + ((colB) ^ ((((row) >> 1) & 7) << 4)))
#define SBAR() __builtin_amdgcn_sched_barrier(0)
#define ATT_LAS __attribute__((address_space(3)))
__device__ __forceinline__ int v_st(int k, int c) { const int kk = (k & ~0xC) | ((k & 4) << 1) | ((k & 8) >> 1); return ((kk >> 3) * 4 + (c >> 5)) * 512 + ((kk & 7) * 32 + (c & 31)) * 2; }
__device__ __forceinline__ int v_rd_base(int lane) { return ((lane & 3) << 3) | (((lane >> 2) & 3) << 6) | (((lane >> 4) & 1) << 5) | (((lane >> 5) & 1) << 8); }
constexpr int v_rd_off(int d0, int ks, int half) { return d0 * 512 + ks * 4096 + half * 2048; }
__device__ __forceinline__ int crow(int r, int hi) { return (r & 3) + 8 * (r >> 2) + 4 * hi; }
__device__ __forceinline__ unsigned cvtpk(float lo, float hi) { unsigned r; asm volatile("v_cvt_pk_bf16_f32 %0, %1, %2" : "=v"(r) : "v"(lo), "v"(hi)); return r; }
__device__ __forceinline__ void mask_tile(f32x16& p0, f32x16& p1, int dq) {
    const float NEG = -__builtin_inff();
#pragma unroll
    for (int r = 0; r < 16; ++r) {
        const int c = (r & 3) + 8 * (r >> 2);
        if ((unsigned)(dq - c) >= WBIG) p0[r] = NEG;
        if ((unsigned)(dq - c - 32) >= WBIG) p1[r] = NEG;
    }
}
constexpr float THR = 8.f;
__device__ __forceinline__ void partialSM(f32x16& p0, f32x16& p1, float& m_reg, float& mn, float& alpha) {
    constexpr float SCALE = MLA_SCALE;
    float pmax = p0[0];
#pragma unroll
    for (int r = 1; r < 16; ++r) pmax = fmaxf(pmax, p0[r]);
#pragma unroll
    for (int r = 0; r < 16; ++r) pmax = fmaxf(pmax, p1[r]);
    { auto rr = __builtin_amdgcn_permlane32_swap(__float_as_uint(pmax), __float_as_uint(pmax), false, false);
      pmax = fmaxf(__uint_as_float(rr[0]), __uint_as_float(rr[1])); }
    constexpr float C2 = LOG2E * SCALE;
    if (__builtin_expect(__all((pmax - m_reg) * SCALE <= THR), 1)) { mn = m_reg; alpha = 1.f; }
    else { mn = fmaxf(m_reg, pmax); alpha = __builtin_amdgcn_exp2f((m_reg - mn) * C2); m_reg = mn; }
    const float mnL = -mn * C2;
#pragma unroll
    for (int r = 0; r < 16; ++r) p0[r] = fmaf(p0[r], C2, mnL);
#pragma unroll
    for (int r = 0; r < 16; ++r) p1[r] = fmaf(p1[r], C2, mnL);
#pragma unroll
    for (int r = 0; r < 16; ++r) p0[r] = __builtin_amdgcn_exp2f(p0[r]);
}
#define PK4(P, B_, OUT) do { unsigned a0 = cvtpk(P[B_+0], P[B_+1]), a1 = cvtpk(P[B_+2], P[B_+3]);                          \
        unsigned b0 = cvtpk(P[B_+4], P[B_+5]), b1 = cvtpk(P[B_+6], P[B_+7]);                                             \
        auto r0 = __builtin_amdgcn_permlane32_swap(a0, b0, false, false); auto r1 = __builtin_amdgcn_permlane32_swap(a1, b1, false, false); \
        u32x4 w = {r0[0], r1[0], r0[1], r1[1]}; OUT = *reinterpret_cast<bf16x8*>(&w); } while (0)
__device__ __forceinline__ void finishSM(f32x16& p0, f32x16& p1, float alpha, float& l_reg, bf16x8& pa0, bf16x8& pa1, bf16x8& pa2, bf16x8& pa3) {
#pragma unroll
    for (int r = 0; r < 16; ++r) p1[r] = __builtin_amdgcn_exp2f(p1[r]);
    float ps = 0;
#pragma unroll
    for (int r = 0; r < 16; ++r) ps += p0[r];
#pragma unroll
    for (int r = 0; r < 16; ++r) ps += p1[r];
    { auto rr = __builtin_amdgcn_permlane32_swap(__float_as_uint(ps), __float_as_uint(ps), false, false);
      ps = __uint_as_float(rr[0]) + __uint_as_float(rr[1]); }
    l_reg = l_reg * alpha + ps;
    PK4(p0, 0, pa0); PK4(p0, 8, pa1); PK4(p1, 0, pa2); PK4(p1, 8, pa3);
}
constexpr float THR2 = 8.f * LOG2E;
__device__ __forceinline__ float max3f(float a, float b, float c) { return __builtin_fmaxf(__builtin_fmaxf(a, b), c); }
__device__ __forceinline__ void softmax_c(f32x16& p0, f32x16& p1, bool first, float& m_ref, f32x16& negm, float& l_reg, float& alpha, bf16x8& pa0, bf16x8& pa1, bf16x8& pa2, bf16x8& pa3) {
    float a = max3f(p0[0], p0[1], p1[0]), b = max3f(p0[2], p0[3], p1[1]); a = max3f(a, p1[2], p1[3]);
#pragma unroll
    for (int r = 4; r < 16; r += 4) { a = max3f(a, p0[r], p0[r + 1]); b = max3f(b, p0[r + 2], p0[r + 3]); a = max3f(a, p1[r], p1[r + 1]); b = max3f(b, p1[r + 2], p1[r + 3]); }
    float pmax = __builtin_fmaxf(a, b);
    { auto rr = __builtin_amdgcn_permlane32_swap(__float_as_uint(pmax), __float_as_uint(pmax), false, false);
      pmax = __builtin_fmaxf(__uint_as_float(rr[0]), __uint_as_float(rr[1])); }
    alpha = 1.f;
    if (__builtin_expect(first || __any(pmax > THR2), 0)) {
        const float dl = first ? pmax : __builtin_fmaxf(pmax, 0.f); m_ref += dl;
#pragma unroll
        for (int r = 0; r < 16; ++r) { p0[r] -= dl; p1[r] -= dl; }
#pragma unroll
        for (int r = 0; r < 16; ++r) negm[r] = -m_ref;
        alpha = first ? 1.f : __builtin_amdgcn_exp2f(-dl);
    }
#pragma unroll
    for (int r = 0; r < 16; ++r) { p0[r] = __builtin_amdgcn_exp2f(p0[r]); p1[r] = __builtin_amdgcn_exp2f(p1[r]); }
    float ps = 0;
#pragma unroll
    for (int r = 0; r < 16; ++r) ps += p0[r];
#pragma unroll
    for (int r = 0; r < 16; ++r) ps += p1[r];
    { auto rr = __builtin_amdgcn_permlane32_swap(__float_as_uint(ps), __float_as_uint(ps), false, false);
      ps = __uint_as_float(rr[0]) + __uint_as_float(rr[1]); }
    l_reg = l_reg * alpha + ps;
    PK4(p0, 0, pa0); PK4(p0, 8, pa1); PK4(p1, 0, pa2); PK4(p1, 8, pa3);
}
template <int KB, bool ROPE, int NREG = 8, bool CINIT = false>
__device__ __forceinline__ void qkt(f32x16& p0, f32x16& p1, const char* lds, int r32, int hi, const bf16x8* qr, const char* qpark = nullptr, const f32x16* cinit = nullptr) {
    if constexpr (!CINIT) { p0 = f32x16{}; p1 = f32x16{}; }
    int ysw = (hi * 16) ^ ((r32 & 15) << 4); asm volatile("" : "+v"(ysw));
    const char* krow = lds + kn_off(KB) + r32 * 256;
#pragma unroll
    for (int d0 = 0; d0 < 8; ++d0) { const char* a = krow + ((d0 * 32) ^ ysw);
        bf16x8 b0 = *reinterpret_cast<const bf16x8*>(a);
        bf16x8 b1 = *reinterpret_cast<const bf16x8*>(a + 32 * 256);
        bf16x8 qf; if (d0 < NREG) qf = qr[d0]; else qf = *reinterpret_cast<const bf16x8*>(qpark + (d0 - NREG) * 1024);
        if (CINIT && d0 == 0) { p0 = __builtin_amdgcn_mfma_f32_32x32x16_bf16(b0, qf, *cinit, 0, 0, 0); p1 = __builtin_amdgcn_mfma_f32_32x32x16_bf16(b1, qf, *cinit, 0, 0, 0); }
        else { p0 = __builtin_amdgcn_mfma_f32_32x32x16_bf16(b0, qf, p0, 0, 0, 0);
               p1 = __builtin_amdgcn_mfma_f32_32x32x16_bf16(b1, qf, p1, 0, 0, 0); } }
    if constexpr (ROPE) {
#pragma unroll
        for (int d0 = 0; d0 < 4; ++d0) { const char* a = lds + OFF_KR + KB * SHM_KR + KRSWZ(r32, (d0 * 16 + hi * 8) * 2);
            bf16x8 b0 = *reinterpret_cast<const bf16x8*>(a);
            bf16x8 b1 = *reinterpret_cast<const bf16x8*>(a + 32 * 128);
            bf16x8 qf; if (NREG >= 12) qf = qr[8 + d0]; else qf = *reinterpret_cast<const bf16x8*>(qpark + d0 * 1024);
            p0 = __builtin_amdgcn_mfma_f32_32x32x16_bf16(b0, qf, p0, 0, 0, 0);
            p1 = __builtin_amdgcn_mfma_f32_32x32x16_bf16(b1, qf, p1, 0, 0, 0); }
    }
}
template <int VB>
__device__ __forceinline__ void pv_tile(f32x16* o, int vb0, bf16x8 pa0, bf16x8 pa1, bf16x8 pa2, bf16x8 pa3) {
    const int vbx = VB == 2 ? vb0 + v_off(2) : vb0;
#define TRRD(dst, off) asm volatile("ds_read_b64_tr_b16 %0, %1 offset:%2" : "=&v"(dst) : "v"(vbx), "i"(off) : "memory")
#define PV_D0(d0) do { s16x4 l0, l1, l2, l3, h0, h1, h2, h3; constexpr int b_ = (VB == 2 ? 0 : v_off(VB)) + v_rd_off(d0, 0, 0); \
        TRRD(l0, b_); TRRD(h0, b_ + 2048); TRRD(l1, b_ + 4096); TRRD(h1, b_ + 6144); TRRD(l2, b_ + 8192); TRRD(h2, b_ + 10240); TRRD(l3, b_ + 12288); TRRD(h3, b_ + 14336); \
        asm volatile("s_waitcnt lgkmcnt(0)" ::: "memory"); SBAR();   \
        o[d0] = __builtin_amdgcn_mfma_f32_32x32x16_bf16(pa0, (bf16x8){l0[0], l0[1], l0[2], l0[3], h0[0], h0[1], h0[2], h0[3]}, o[d0], 0, 0, 0);   \
        o[d0] = __builtin_amdgcn_mfma_f32_32x32x16_bf16(pa1, (bf16x8){l1[0], l1[1], l1[2], l1[3], h1[0], h1[1], h1[2], h1[3]}, o[d0], 0, 0, 0);   \
        o[d0] = __builtin_amdgcn_mfma_f32_32x32x16_bf16(pa2, (bf16x8){l2[0], l2[1], l2[2], l2[3], h2[0], h2[1], h2[2], h2[3]}, o[d0], 0, 0, 0);   \
        o[d0] = __builtin_amdgcn_mfma_f32_32x32x16_bf16(pa3, (bf16x8){l3[0], l3[1], l3[2], l3[3], h3[0], h3[1], h3[2], h3[3]}, o[d0], 0, 0, 0); } while (0)
    PV_D0(0); PV_D0(1); PV_D0(2); PV_D0(3);
#undef PV_D0
#undef TRRD
}
#define VMW() asm volatile("s_waitcnt vmcnt(0)" ::: "memory")
__device__ __forceinline__ float silu_f(float z) { return z * __builtin_amdgcn_rcpf(1.0f + __builtin_amdgcn_exp2f(-LOG2E * z)); }
template <int CTRL> __device__ __forceinline__ float dpp_f(float v) { return __builtin_bit_cast(float, __builtin_amdgcn_update_dpp(0, __builtin_bit_cast(int, v), CTRL, 0xf, 0xf, true)); }
template <bool ALLOK>
__device__ __forceinline__ void store_o_t(const f32x16* o, const float* sc, bf16_t* Aw, const u32x4* zz, float* ssq, int qlo, int r32, int hi, char* stg) {
    const int lane = hi * 32 + r32, rr = lane >> 4, ch = lane & 15; const bool odd = (r32 & 1) != 0;
    float ss[16];
    char* sw = stg + ((odd ? 32 + r32 - 1 : r32) * 2);
#pragma unroll
    for (int r = 0; r < 16; ++r) { const int orow = crow(r, hi); float v[4]; ss[r] = 0.f;
#pragma unroll
        for (int d0 = 0; d0 < 4; ++d0) { v[d0] = o[d0][r] * sc[r]; ss[r] += v[d0] * v[d0]; }
#pragma unroll
        for (int dp = 0; dp < 4; dp += 2) { const float x0 = dpp_f<0xB1>(v[dp]), x1 = dpp_f<0xB1>(v[dp + 1]);
            *(unsigned*)(sw + orow * 256 + dp * 64) = odd ? cvtpk(x1, v[dp + 1]) : cvtpk(v[dp], x0); } }
#pragma unroll
    for (int r = 0; r < 16; ++r) ss[r] += dpp_f<0x128>(ss[r]);
#pragma unroll
    for (int r = 0; r < 16; ++r) ss[r] += dpp_f<0x124>(ss[r]);
#pragma unroll
    for (int r = 0; r < 16; ++r) ss[r] += dpp_f<0x122>(ss[r]);
#pragma unroll
    for (int r = 0; r < 16; ++r) ss[r] += dpp_f<0x121>(ss[r]);
    float sx[16];
#pragma unroll
    for (int r = 0; r < 16; ++r) sx[r] = __builtin_bit_cast(float, __builtin_amdgcn_ds_swizzle(__builtin_bit_cast(int, ss[r]), 0x401F));
    asm volatile("s_waitcnt lgkmcnt(0)" ::: "memory");
    if (r32 == 0) {
#pragma unroll
        for (int r = 0; r < 16; ++r) { const int orow = crow(r, hi); if (ALLOK || qlo + orow >= 0) ssq[(long)orow * 32] = ss[r] + sx[r]; } }
#pragma unroll
    for (int i = 0; i < 8; ++i) { const int row = 4 * i + rr; const u32x4 y = *(const u32x4*)(stg + row * 256 + ch * 16); const u32x4 z = zz[i]; u32x4 w;
#pragma unroll
        for (int e = 0; e < 4; ++e) { const float y0 = __builtin_bit_cast(float, y[e] << 16), y1 = __builtin_bit_cast(float, y[e] & 0xffff0000u);
            const float z0 = __builtin_bit_cast(float, z[e] << 16), z1 = __builtin_bit_cast(float, z[e] & 0xffff0000u); w[e] = cvtpk(y0 * silu_f(z0), y1 * silu_f(z1)); }
        if (ALLOK || qlo + row >= 0) *(u32x4*)(Aw + (long)row * LDO + ch * 8) = w; }
}
__device__ __forceinline__ void load_z(u32x4* zz, const bf16_t* Zw, int qlo, int lane) {
    const int rr = lane >> 4, ch = lane & 15;
#pragma unroll
    for (int i = 0; i < 8; ++i) zz[i] = (qlo + 4 * i + rr >= 0) ? *(const u32x4*)(Zw + (long)(4 * i + rr) * LDO + ch * 8) : (u32x4){0u, 0u, 0u, 0u};
}
__device__ __forceinline__ void store_o(const f32x16* o, const float* sc, bf16_t* Aw  , const u32x4* zz, float* ssq  , int qlo, int r32, int hi, char* stg) {
    if (qlo >= 0) store_o_t<true>(o, sc, Aw, zz, ssq, qlo, r32, hi, stg); else store_o_t<false>(o, sc, Aw, zz, ssq, qlo, r32, hi, stg);
}

__device__ __forceinline__ void mla_block(const bf16_t* Qh, const bf16_t* KNh, const bf16_t* KRh, const bf16_t* Vh, bf16_t* Oh, const bf16_t* Zh, float* ssq, int qb, char* lds) {
    int tid_ = threadIdx.x; asm volatile("" : "+v"(tid_));
    const int tid = tid_, wid = __builtin_amdgcn_readfirstlane(tid >> 6), lane = tid & 63, r32 = lane & 31, hi = lane >> 5;
    const int P0 = 256 * qb - 240, NT = 4 * qb + 1;
    const int qlo = P0 + wid * QBLK, qm = qlo + r32 - 4 * hi;
    float* ws = (float*)(lds + OFF_WS) + wid * 64; float* li_l = ws; float* al_l = ws + 32;
    float m_ref = 0.f, l_reg = 0; f32x16 o[4] = {}; f32x16 negm = {};
    const int vb0 = (int)(uintptr_t)lds + v_rd_base(lane);
    int gk0, gk1, gv0, gv1, gkr;
    { const int o0 = 1024 * (2 * wid) + 16 * lane, o1 = o0 + 1024;
      { const int row = o0 >> 8, cb = (o0 & 255) ^ ((row & 15) << 4); gk0 = row * LDK + (cb >> 1); }
      { const int row = o1 >> 8, cb = (o1 & 255) ^ ((row & 15) << 4); gk1 = row * LDK + (cb >> 1); }
      { const int sub = o0 >> 9, w_ = o0 & 511, kk = (sub >> 2) * 8 + (w_ >> 6), c = (sub & 3) * 32 + ((w_ & 63) >> 1), k = (kk & ~0xC) | ((kk & 4) << 1) | ((kk & 8) >> 1); gv0 = k * LDV + c; }
      { const int sub = o1 >> 9, w_ = o1 & 511, kk = (sub >> 2) * 8 + (w_ >> 6), c = (sub & 3) * 32 + ((w_ & 63) >> 1), k = (kk & ~0xC) | ((kk & 4) << 1) | ((kk & 8) >> 1); gv1 = k * LDV + c; }
      { const int o2 = 1024 * wid + 16 * lane, row = o2 >> 7, cb = (o2 & 127) ^ (((row >> 1) & 7) << 4); gkr = row * LDKR + (cb >> 1); } }
    ATT_LAS char* ldsl = (ATT_LAS char*)lds;
#define DMA16(gp, lo) __builtin_amdgcn_global_load_lds((const unsigned*)(gp), (ATT_LAS unsigned*)(ldsl + (lo)), 16, 0, 0)
#define SDMA(t, bf) do { const long k0_ = (long)(t) * KVBLK; \
        DMA16(Vh + k0_ * LDV + gv0, OFF_V + (bf) * SHM_V + 2048 * wid); DMA16(Vh + k0_ * LDV + gv1, OFF_V + (bf) * SHM_V + 2048 * wid + 1024); \
        DMA16(KNh + k0_ * LDK + gk0, OFF_KN + (bf) * SHM_KN + 2048 * wid); DMA16(KNh + k0_ * LDK + gk1, OFF_KN + (bf) * SHM_KN + 2048 * wid + 1024); \
        DMA16(KRh + k0_ * LDKR + gkr, OFF_KR + (bf) * SHM_KR + 1024 * wid); } while (0)
#define RESC(a) do { if (__any((a) < 1.f)) { if (hi == 0) al_l[r32] = (a); asm volatile("s_waitcnt lgkmcnt(0)" ::: "memory");              \
                     for (int d_ = 0; d_ < 4; ++d_) for (int r = 0; r < 16; ++r) o[d_][r] *= al_l[crow(r, hi)]; } } while (0)
#define MASKT(P0_, P1_, t) do { const int kb_ = (t) * KVBLK; if (kb_ + KVBLK - 1 > qlo) mask_tile(P0_, P1_, qm - kb_); } while (0)
    SDMA(0, 0);
    bf16x8 qr[12];
    { int qrow = qlo + r32; qrow = qrow < 0 ? 0 : qrow; const bf16_t* qp = Qh + (long)qrow * LDQM + hi * 8;
#pragma unroll
      for (int d0 = 0; d0 < 12; ++d0) qr[d0] = *(const bf16x8*)(qp + d0 * 16); }
    VMW();
    __syncthreads();
    f32x16 p0, p1; float al; bf16x8 pa0, pa1, pa2, pa3;
#define MLA_STEP(t, BUF) do { const int t_ = (t);                                                         \
        if (t_ + 1 < NT) { SDMA(t_ + 1, (BUF) ^ 1); SBAR(); }                                              \
        if (t_ * KVBLK <= qlo + QBLK - 1) {                                                                \
            qkt<BUF, true, 12, true>(p0, p1, lds, r32, hi, qr, nullptr, &negm);                            \
            MASKT(p0, p1, t_); softmax_c(p0, p1, t_ == 0, m_ref, negm, l_reg, al, pa0, pa1, pa2, pa3); RESC(al); SBAR();   \
            pv_tile<BUF>(o, vb0, pa0, pa1, pa2, pa3); }                                                   \
        VMW();                                                                                             \
        __syncthreads(); } while (0)
    for (int t = 0; t + 1 < NT; t += 2) { MLA_STEP(t, 0); MLA_STEP(t + 1, 1); }
    MLA_STEP(NT - 1, 0);
#undef MLA_STEP
    u32x4 zz[8]; load_z(zz, Zh + (long)qlo * LDO, qlo, lane);
    if (hi == 0) li_l[r32] = l_reg; asm volatile("s_waitcnt lgkmcnt(0)" ::: "memory");
    float rli[16];
#pragma unroll
    for (int r = 0; r < 16; ++r) rli[r] = __builtin_amdgcn_rcpf(li_l[crow(r, hi)]);
    store_o(o, rli, Oh + (long)qlo * LDO, zz, ssq + (long)qlo * 32, qlo, r32, hi, lds + wid * 8192);
    __syncthreads();
#undef MASKT
#undef RESC
#undef SDMA
#undef DMA16
}

__device__ __forceinline__ void sb_elem(f32x16& p0, f32x16& p1, float& carry, bool need_mask, int dq, bool hi0, bf16x8& pa0, bf16x8& pa1, bf16x8& pa2, bf16x8& pa3) {
    f32x16 m0, m1;
    { const f32x16 y0 = p0, y1 = p1; f32x16 e0, e1;
#pragma unroll
      for (int r = 0; r < 16; ++r) { e0[r] = __builtin_amdgcn_exp2f(__builtin_amdgcn_fmed3f(y0[r], 126.f, -__builtin_inff())); e1[r] = __builtin_amdgcn_exp2f(__builtin_amdgcn_fmed3f(y1[r], 126.f, -__builtin_inff())); }
      const f32x16 t0 = e0 + 1.0f, t1 = e1 + 1.0f;
#pragma unroll
      for (int r = 0; r < 16; ++r) { p0[r] = __builtin_amdgcn_rcpf(t0[r]); p1[r] = __builtin_amdgcn_rcpf(t1[r]); }
      m0 = e0 * p0; m1 = e1 * p1; }
    if (need_mask) {
#pragma unroll
        for (int r = 0; r < 16; ++r) { const int c = (r & 3) + 8 * (r >> 2);
            if ((unsigned)(dq - c) >= WBIG) { p0[r] = 0.f; m0[r] = 1.f; }
            if ((unsigned)(dq - c - 32) >= WBIG) { p1[r] = 0.f; m1[r] = 1.f; } }
    }
    float T[8], GH[8];
#pragma unroll
    for (int m = 0; m < 8; ++m) { const float g = m < 4 ? (m0[4 * m] * m0[4 * m + 1]) * (m0[4 * m + 2] * m0[4 * m + 3]) : (m1[4 * (m - 4)] * m1[4 * (m - 4) + 1]) * (m1[4 * (m - 4) + 2] * m1[4 * (m - 4) + 3]);
        auto rr = __builtin_amdgcn_permlane32_swap(__float_as_uint(g), __float_as_uint(g), false, false);
        T[m] = __uint_as_float(rr[0]) * __uint_as_float(rr[1]); GH[m] = __uint_as_float(rr[1]); }
    float SS = carry;
#pragma unroll
    for (int m = 7; m >= 0; --m) {
        const float t3 = SS * (hi0 ? GH[m] : 1.0f);
        if (m < 4) { const float t2 = t3 * m0[4 * m + 3], t1 = t2 * m0[4 * m + 2], t0 = t1 * m0[4 * m + 1];
            p0[4 * m + 3] *= t3; p0[4 * m + 2] *= t2; p0[4 * m + 1] *= t1; p0[4 * m] *= t0; }
        else { const int q = 4 * (m - 4); const float t2 = t3 * m1[q + 3], t1 = t2 * m1[q + 2], t0 = t1 * m1[q + 1];
            p1[q + 3] *= t3; p1[q + 2] *= t2; p1[q + 1] *= t1; p1[q] *= t0; }
        SS *= T[m];
    }
    carry = SS;
    PK4(p0, 0, pa0); PK4(p0, 8, pa1); PK4(p1, 0, pa2); PK4(p1, 8, pa3);
}
constexpr int OFF_SBFLAG = 131072 + 8192;
struct SbHalf { const bf16_t* Qh; const bf16_t* Kh; const bf16_t* Vh; const bf16_t* Zh; bf16_t* Oh; float* ssq; int hb; };
__device__ __forceinline__ void sb_block2(const SbHalf& HA, const SbHalf& HB, char* lds) {
    int tid_ = threadIdx.x; asm volatile("" : "+v"(tid_));
    const int tid = tid_, wid = __builtin_amdgcn_readfirstlane(tid >> 6), lane = tid & 63, r32 = lane & 31, hi = lane >> 5;
    const int g = wid >> 2, w4 = wid & 3;
    const bf16_t* Qh = g ? HB.Qh : HA.Qh; const bf16_t* Kh = g ? HB.Kh : HA.Kh; const bf16_t* Vh = g ? HB.Vh : HA.Vh; const bf16_t* Zh = g ? HB.Zh : HA.Zh;
    bf16_t* Oh = g ? HB.Oh : HA.Oh; float* ssq = g ? HB.ssq : HA.ssq; const int hb = g ? HB.hb : HA.hb;
    const int NT = 2 * hb + 1, smax = 2 * (HA.hb > HB.hb ? HA.hb : HB.hb) + 1;
    const int qlo = 128 * hb - 112 + w4 * QBLK, qm = qlo + r32 - 4 * hi - 1;
    char* lg = lds + g * 65536;
    f32x16 o[4] = {}; float carry = 1.f; const bool hi0 = hi == 0;
    const int vb0 = (int)(uintptr_t)lg + v_rd_base(lane);
    int gk[4], gv[4];
#pragma unroll
    for (int i = 0; i < 4; ++i) { const int o_ = 1024 * (4 * w4 + i) + 16 * lane;
      { const int row = o_ >> 8, cb = (o_ & 255) ^ ((row & 15) << 4); gk[i] = row * LDK + (cb >> 1); }
      { const int sub = o_ >> 9, w_ = o_ & 511, kk = (sub >> 2) * 8 + (w_ >> 6), c = (sub & 3) * 32 + ((w_ & 63) >> 1), k = (kk & ~0xC) | ((kk & 4) << 1) | ((kk & 8) >> 1); gv[i] = k * LDV + c; } }
    ATT_LAS char* ldsl = (ATT_LAS char*)lg;
#define DMA16(gp, lo) __builtin_amdgcn_global_load_lds((const unsigned*)(gp), (ATT_LAS unsigned*)(ldsl + (lo)), 16, 0, 0)
#define SDMA(t, bf) do { const long k0_ = (long)(t) * KVBLK; _Pragma("unroll") for (int i_ = 0; i_ < 4; ++i_) { \
        DMA16(Vh + k0_ * LDV + gv[i_], OFF_V + (bf) * SHM_V + 4096 * w4 + 1024 * i_); DMA16(Kh + k0_ * LDK + gk[i_], OFF_KN + (bf) * SHM_KN + 4096 * w4 + 1024 * i_); } } while (0)
    SDMA(NT - 1, 0);
    bf16x8 qr[8];
    { int qrow = qlo + r32; qrow = qrow < 0 ? 0 : qrow; const bf16_t* qp = Qh + (long)qrow * LDQS + hi * 8;
#pragma unroll
      for (int d0 = 0; d0 < 8; ++d0) qr[d0] = *(const bf16x8*)(qp + d0 * 16); }
    VMW();
    __syncthreads();
    f32x16 p0, p1; bf16x8 pa0, pa1, pa2, pa3;
    int* flags = (int*)(lds + OFF_SBFLAG); bool wdone = false, stop = false; const bool rowneg = qlo + r32 < 0;
#define SB_STEP(s, BUF) do { const int t_ = NT - 1 - (s); const int kb_ = t_ * KVBLK;     \
        if (t_ > 0) { SDMA(t_ - 1, (BUF) ^ 1); SBAR(); }                                                    \
        if (!wdone && t_ >= 0 && kb_ <= qlo + 30) {                                                         \
            qkt<BUF, false, 8>(p0, p1, lg, r32, hi, qr);                                                  \
            sb_elem(p0, p1, carry, kb_ + KVBLK - 1 >= qlo, qm - kb_, hi0, pa0, pa1, pa2, pa3); SBAR();    \
            pv_tile<BUF>(o, vb0, pa0, pa1, pa2, pa3);                                                     \
            wdone = __all(carry == 0.f || rowneg); }                                                      \
        if (lane == 0) flags[(BUF) * 8 + wid] = (wdone || t_ <= 0) ? 1 : 0;                                 \
        VMW();                                                                                              \
        __syncthreads();                                                                                    \
        { const int* f_ = flags + (BUF) * 8; const int a_ = f_[0] & f_[1] & f_[2] & f_[3] & f_[4] & f_[5] & f_[6] & f_[7];   \
          stop = __builtin_amdgcn_readfirstlane(a_) != 0; } } while (0)
    for (int s_ = 0; s_ < smax && !stop; s_ += 2) { SB_STEP(s_, 0); if (!stop && s_ + 1 < smax) SB_STEP(s_ + 1, 1); }
    u32x4 zz[8]; load_z(zz, Zh + (long)qlo * LDO, qlo, lane);
    float one[16];
#pragma unroll
    for (int r = 0; r < 16; ++r) one[r] = 1.f;
    store_o(o, one, Oh + (long)qlo * LDO, zz, ssq + (long)qlo * 32, qlo, r32, hi, lds + wid * 8192);
    __syncthreads();
#undef SB_STEP
#undef SDMA
#undef DMA16
}
#undef VMW
#undef PK4
#undef SBAR
#undef KSWZ
#undef KRSWZ
#undef ATT_LAS
}

constexpr int NWAVES = 8;
#ifndef MK_MULTI
#define MK_MULTI 0
#endif
constexpr int BATCH = 4, SEQ = 4096, DM = 4096, DEPTH = 4, NMETA = 16, SEQL = SEQ + NMETA;
constexpr int M = BATCH * SEQL;
constexpr int MP = 16640;
constexpr int QL = 1024, KVL = 512, NIN = 12032  , DIN = 11840, NUQ = 3072, NUKV = 4096;
constexpr float EPS = 1e-6f;
constexpr size_t MiB = 1u << 20;
constexpr size_t al2(size_t x) { return (x + 2 * MiB - 1) / (2 * MiB) * (2 * MiB); }
constexpr size_t WS_CTL = 0, CTL_ZERO_BYTES = 1 * MiB;
constexpr size_t WS_ROPE = 2 * MiB;
constexpr size_t WS_WIN = 4 * MiB;
constexpr size_t WS_WUQ = WS_WIN + al2((size_t)DEPTH * NIN * DM * 2);
constexpr size_t WS_WUKV = WS_WUQ + al2((size_t)DEPTH * NUQ * QL * 2);
constexpr size_t WS_WO = WS_WUKV + al2((size_t)DEPTH * NUKV * KVL * 2);
constexpr size_t WS_SSQ = WS_WO + al2((size_t)DEPTH * DM * DM * 2);
constexpr size_t WS_RSTD = WS_SSQ + al2((size_t)MP * 64 * 4);
constexpr size_t WS_U = WS_RSTD + al2((size_t)MP * 4);
constexpr size_t WS_SSQQ = WS_U + al2((size_t)MP * DM * 2);
constexpr size_t WS_SSQKV = WS_SSQQ + al2((size_t)MP * 16 * 4);
constexpr size_t WS_CQN = WS_SSQKV + al2((size_t)MP * 8 * 4);
constexpr size_t WS_CKVN = WS_CQN + al2((size_t)MP * QL * 2);
constexpr size_t WS_KR = WS_CKVN + al2((size_t)MP * KVL * 2);
constexpr size_t WS_Z = WS_KR + al2((size_t)MP * 64 * 2);
constexpr size_t WS_QSB = WS_Z + al2((size_t)MP * 4096 * 2);
constexpr size_t WS_KSB = WS_QSB + al2((size_t)MP * 2048 * 2);
constexpr size_t WS_VSB = WS_KSB + al2((size_t)MP * 2048 * 2);
constexpr size_t WS_QM = WS_VSB + al2((size_t)MP * 2048 * 2);
constexpr size_t WS_KM = WS_QM + al2((size_t)MP * 3072 * 2);
constexpr size_t WS_VM = WS_KM + al2((size_t)MP * 2048 * 2);
constexpr size_t WS_Y = WS_VM + al2((size_t)MP * 2048 * 2);
constexpr size_t WS_A = WS_Y + al2((size_t)MP * 4096 * 2);
constexpr size_t WS_SLAB = WS_A + al2((size_t)MP * 4096 * 2);
constexpr size_t WS_SSQY = WS_SLAB + al2((size_t)16 * 64 * 4096 * 4);
constexpr size_t WS_RATIO = WS_SSQY + al2((size_t)MP * 32 * 4);
constexpr size_t WS_RSB = WS_RATIO + al2((size_t)MP * 4);
constexpr size_t WS_END = WS_RSB + al2((size_t)MP * 4);
constexpr int MFULL = 16384;
constexpr int CW_BAR = 4096;
constexpr int RING_OFF = 0, RING_BYTES = 131072;
constexpr int LDSCTL_OFF = RING_BYTES, MISC_OFF = LDSCTL_OFF + 320;
constexpr int LDS_BYTES = 147456;
static_assert(att::ATT_LDS <= RING_BYTES && att::OFF_SBFLAG + 256 <= LDS_BYTES && att::OFF_SBFLAG >= LDSCTL_OFF + 4096, "attention LDS");

#define GAS __attribute__((address_space(1)))
#define LAS __attribute__((address_space(3)))
typedef unsigned short bf16;
typedef unsigned v4u __attribute__((ext_vector_type(4)));
typedef unsigned v2u __attribute__((ext_vector_type(2)));
typedef float f32x4 __attribute__((ext_vector_type(4)));
typedef GAS unsigned gu32;
#define RLX_AGENT __ATOMIC_RELAXED, __HIP_MEMORY_SCOPE_AGENT
#define LDS_WAIT() asm volatile("s_waitcnt lgkmcnt(0)" ::: "memory")
__device__ __forceinline__ unsigned f2bf(float f) { unsigned u = __builtin_bit_cast(unsigned, f); return (u + 0x7fffu + ((u >> 16) & 1u)) >> 16; }
__device__ __forceinline__ unsigned pk2(float lo, float hi) { return f2bf(lo) | (f2bf(hi) << 16); }
__device__ __forceinline__ float bflo(unsigned w) { return __builtin_bit_cast(float, w << 16); }
__device__ __forceinline__ float bfhi(unsigned w) { return __builtin_bit_cast(float, w & 0xffff0000u); }
#define XB_TMO      128
#define XB_XCNT(j)  (256  + 64 * (j))
#define XB_XSUB(j)  (1280 + 64 * (j))
#define XB_XGEN(j)  (2304 + 64 * (j))
#define XB_TOP      3328
#define XB_TOPGEN   3392
#define XCD_BAR_WORDS 3456
#define XB_SPIN_CAP (1u << 18)

__device__ __forceinline__ unsigned xb_ld(unsigned* p)              { return __hip_atomic_load(p, __ATOMIC_RELAXED, __HIP_MEMORY_SCOPE_AGENT); }
__device__ __forceinline__ unsigned xb_add(unsigned* p, unsigned v) { return __hip_atomic_fetch_add(p, v, __ATOMIC_RELAXED, __HIP_MEMORY_SCOPE_AGENT); }
__device__ __forceinline__ unsigned xb_xcc_id() { return (unsigned)__builtin_amdgcn_s_getreg((3 << 11) | 20) & 0xFu; }
#define XB_SPIN(cond, bar) do { unsigned _sp = 0; while (cond) { __builtin_amdgcn_s_sleep(1); \
    if ((++_sp & 255u) == 0u) { if (xb_ld(&(bar)[XB_TMO])) break; if (_sp > XB_SPIN_CAP) { atomicAdd(&(bar)[XB_TMO], 1u); break; } } } } while (0)

struct XcdBarrier {
    unsigned* bar; unsigned x;
    volatile LAS unsigned* st;
};

__device__ __forceinline__ XcdBarrier xcd_barrier_post(unsigned* bar, volatile LAS unsigned* st) {
    XcdBarrier b; b.bar = bar; b.x = xb_xcc_id(); b.st = st;
    if (threadIdx.x == 0) (void)xb_add(&bar[XB_XCNT(b.x)], 1u);
    return b;
}
__device__ __forceinline__ void xcd_barrier_complete(unsigned* bar, unsigned x, unsigned& nloc, unsigned& nx) {
    const unsigned G = gridDim.x * gridDim.y * gridDim.z;
    unsigned sum, cnt, mine, sp = 0u;
    for (;;) {
        sum = 0u; cnt = 0u; mine = 0u;
#pragma unroll
        for (unsigned j = 0; j < 16; ++j) { const unsigned c = xb_ld(&bar[XB_XCNT(j)]); sum += c; cnt += (c > 0u) ? 1u : 0u; mine = (j == x) ? c : mine; }
        if (sum == G) break;
        __builtin_amdgcn_s_sleep(1);
        if ((++sp & 255u) == 0u) { if (xb_ld(&bar[XB_TMO])) break; if (sp > XB_SPIN_CAP) { atomicAdd(&bar[XB_TMO], 1u); break; } }
    }
    nloc = mine > 0u ? mine : 1u; nx = cnt > 0u ? cnt : 1u;
}

__device__ __forceinline__ void xcd_barrier(const XcdBarrier& b) {
    asm volatile("s_waitcnt vmcnt(0)" ::: "memory");
    __syncthreads();
    if (threadIdx.x == 0) {
        unsigned* bar = b.bar;
        __builtin_amdgcn_s_waitcnt(0);
        unsigned nloc = b.st[0], nx = b.st[1];
        if (nloc == 0u) { xcd_barrier_complete(bar, b.x, nloc, nx); b.st[0] = nloc; b.st[1] = nx; }
        const unsigned old = xb_add(&bar[XB_XSUB(b.x)], 1u);
        const unsigned gen = old / nloc;
        if (old + 1u == (gen + 1u) * nloc) {
            __builtin_amdgcn_fence(__ATOMIC_RELEASE, "agent");
            asm volatile("s_waitcnt vmcnt(0)" ::: "memory");
            const unsigned og = xb_add(&bar[XB_TOP], 1u);
            const unsigned tg = og / nx;
            if (og + 1u == (tg + 1u) * nx) xb_add(&bar[XB_TOPGEN], 1u);
            else XB_SPIN(xb_ld(&bar[XB_TOPGEN]) == tg, bar);
            __builtin_amdgcn_fence(__ATOMIC_ACQUIRE, "agent");
            xb_add(&bar[XB_XGEN(b.x)], 1u);
            asm volatile("s_waitcnt vmcnt(0)" ::: "memory");
        } else {
            XB_SPIN(xb_ld(&bar[XB_XGEN(b.x)]) == gen, bar);
            __builtin_amdgcn_fence(__ATOMIC_ACQUIRE, "agent");
            asm volatile("s_waitcnt vmcnt(0)" ::: "memory");
        }
    }
    __syncthreads();
}

struct Frame {
    LAS unsigned char* lds;
    volatile LAS unsigned* MISC;
    gu32* ctl;
    int tid, lane, wave, vcu, G;
};
__device__ __forceinline__ float wave_sum(float v) {
#pragma unroll
    for (int o = 1; o < 64; o <<= 1) v += __shfl_xor(v, o);
    return v;
}
__device__ __forceinline__ void transpose_item(const float* W, int N, int K, bf16* WT, int src_col0, int dst_row0, int k0, LAS float* scr, int lane, const float* gk) {
    float tv[32];
#pragma unroll
    for (int i = 0; i < 32; ++i) { const int kk = 2 * i + (lane >> 5); tv[i] = W[(size_t)(k0 + kk) * N + src_col0 + (lane & 31)]; }
#pragma unroll
    for (int i = 0; i < 32; ++i) { const int kk = 2 * i + (lane >> 5); scr[kk * 33 + (lane & 31)] = gk ? tv[i] * gk[k0 + kk] : tv[i]; }
    LDS_WAIT(); asm volatile("" ::: "memory");
    const int c = lane & 7;
#pragma unroll
    for (int j = 0; j < 4; ++j) { const int n = (lane >> 3) + 8 * j; const LAS float* s = scr + (8 * c) * 33 + n;
        v4u o; o.x = pk2(s[0 * 33], s[1 * 33]); o.y = pk2(s[2 * 33], s[3 * 33]); o.z = pk2(s[4 * 33], s[5 * 33]); o.w = pk2(s[6 * 33], s[7 * 33]);
        *(GAS v4u*)(WT + (size_t)(dst_row0 + n) * K + k0 + 8 * c) = o; }
    LDS_WAIT(); asm volatile("" ::: "memory");
}
template <int MODE>
__device__ __forceinline__ void h_row(const float* src, bf16* HB, int row, bool tail, const float* slab, float* RSTD, const float* g, float* out, int lane) {
    f32x4 v[8][2];
    if (MODE == 0) { const GAS f32x4* sr = (const GAS f32x4*)src + 2 * lane;
#pragma unroll
        for (int j = 0; j < 8; ++j) { v[j][0] = sr[128 * j]; v[j][1] = sr[128 * j + 1]; } }
    else { const GAS v4u* hr = (const GAS v4u*)(HB + (size_t)row * DM) + lane;
#pragma unroll
        for (int j = 0; j < 8; ++j) { const v4u h = hr[64 * j]; v[j][0] = (f32x4){bflo(h.x), bfhi(h.x), bflo(h.y), bfhi(h.y)}; v[j][1] = (f32x4){bflo(h.z), bfhi(h.z), bflo(h.w), bfhi(h.w)}; }
        if (tail) for (int s = 0; s < 16; ++s) { const GAS f32x4* pr = (const GAS f32x4*)(slab + ((size_t)s * 64 + (row - MFULL)) * DM) + 2 * lane;
#pragma unroll
            for (int j = 0; j < 8; ++j) { v[j][0] += pr[128 * j]; v[j][1] += pr[128 * j + 1]; } } }
    float ss = 0.f;
    if (MODE != 2) {
        GAS v4u* hw = (GAS v4u*)(HB + (size_t)row * DM) + lane;
#pragma unroll
        for (int j = 0; j < 8; ++j) { v4u w; w.x = pk2(v[j][0].x, v[j][0].y); w.y = pk2(v[j][0].z, v[j][0].w); w.z = pk2(v[j][1].x, v[j][1].y); w.w = pk2(v[j][1].z, v[j][1].w);
            if (MODE == 0 || tail) hw[64 * j] = w;
#pragma unroll
            for (int e = 0; e < 4; ++e) { const float a = bflo(w[e]), b = bfhi(w[e]); ss += a * a + b * b; } }
        const float rstd = 1.0f / sqrtf(wave_sum(ss) * (1.0f / DM) + EPS);
        if (lane == 0) RSTD[row] = rstd;
    } else {
#pragma unroll
        for (int j = 0; j < 8; ++j) ss += (v[j][0].x * v[j][0].x + v[j][0].y * v[j][0].y) + (v[j][0].z * v[j][0].z + v[j][0].w * v[j][0].w) + (v[j][1].x * v[j][1].x + v[j][1].y * v[j][1].y) + (v[j][1].z * v[j][1].z + v[j][1].w * v[j][1].w);
        const float rstd = 1.0f / sqrtf(wave_sum(ss) * (1.0f / DM) + EPS);
        const int b = row / SEQL, t = row % SEQL;
        GAS f32x4* orow = (GAS f32x4*)(out + ((size_t)b * SEQ + (t - NMETA)) * DM) + 2 * lane; const GAS f32x4* gr = (const GAS f32x4*)g + 2 * lane;
#pragma unroll
        for (int j = 0; j < 8; ++j) { orow[128 * j] = (v[j][0] * rstd) * gr[128 * j]; orow[128 * j + 1] = (v[j][1] * rstd) * gr[128 * j + 1]; }
    }
}
template <int MODE>
__device__ __forceinline__ void h_rows(Frame& F, const float* x, const float* meta, bf16* HB, const float* slab, const float* SSQ, float* RSTD, const float* g, float* out) {
    const int gw = F.vcu * NWAVES + F.wave, NGW = F.G * NWAVES; int lane = F.lane; asm volatile("" : "+v"(lane));
    if (MODE == 0) {
        for (int row = gw; row < MP; row += NGW) {
            if (row >= M) { GAS v4u* hw = (GAS v4u*)(HB + (size_t)row * DM) + lane;
#pragma unroll
                for (int j = 0; j < 8; ++j) hw[64 * j] = (v4u){0u, 0u, 0u, 0u};
                if (lane == 0) RSTD[row] = 0.f;
                continue; }
            const int b = row / SEQL, t = row % SEQL;
            h_row<0>(t < NMETA ? meta + (size_t)t * DM : x + ((size_t)b * SEQ + (t - NMETA)) * DM, HB, row, false, nullptr, RSTD, nullptr, nullptr, lane);
        }
    } else {
        for (int i4 = F.vcu; i4 < (M - MFULL) * 4; i4 += F.G) if ((i4 & 3) == 0) {
            const int row = MFULL + (i4 >> 2), col = 512 * F.wave + 8 * lane;
            const v4u hv = *(const GAS v4u*)(HB + (size_t)row * DM + col);
            f32x4 a0 = (f32x4){bflo(hv.x), bfhi(hv.x), bflo(hv.y), bfhi(hv.y)}, a1 = (f32x4){bflo(hv.z), bfhi(hv.z), bflo(hv.w), bfhi(hv.w)};
            f32x4 s0[16], s1[16];
#pragma unroll
            for (int s = 0; s < 16; ++s) { const GAS f32x4* pr = (const GAS f32x4*)(slab + ((size_t)s * 64 + (row - MFULL)) * DM + col); s0[s] = pr[0]; s1[s] = pr[1]; }
#pragma unroll
            for (int s = 0; s < 16; ++s) { a0 += s0[s]; a1 += s1[s]; }
            float ss;
            if (MODE == 1) { v4u w; w.x = pk2(a0.x, a0.y); w.y = pk2(a0.z, a0.w); w.z = pk2(a1.x, a1.y); w.w = pk2(a1.z, a1.w);
                *(GAS v4u*)(HB + (size_t)row * DM + col) = w; ss = 0.f;
#pragma unroll
                for (int e = 0; e < 4; ++e) { const float p = bflo(w[e]), q = bfhi(w[e]); ss += p * p + q * q; } }
            else ss = (a0.x * a0.x + a0.y * a0.y) + (a0.z * a0.z + a0.w * a0.w) + (a1.x * a1.x + a1.y * a1.y) + (a1.z * a1.z + a1.w * a1.w);
            ss = wave_sum(ss);
            LAS float* red = (LAS float*)(F.lds + RING_OFF);
            if (lane == 0) red[F.wave] = ss;
            __syncthreads();
            float tot = 0.f;
#pragma unroll
            for (int w = 0; w < NWAVES; ++w) tot += red[w];
            const float rstd = 1.0f / sqrtf(tot * (1.0f / DM) + EPS);
            if (MODE == 1) { if (F.wave == 0 && lane == 0) RSTD[row] = rstd; }
            else { const int b = row / SEQL, t = row % SEQL; GAS f32x4* orow = (GAS f32x4*)(out + ((size_t)b * SEQ + (t - NMETA)) * DM + col); const GAS f32x4* gr = (const GAS f32x4*)(g + col);
                orow[0] = (a0 * rstd) * gr[0]; orow[1] = (a1 * rstd) * gr[1]; }
            __syncthreads();
        }
        if (MODE == 1) {
            for (int r4 = gw * 4; r4 < MFULL; r4 += NGW * 4) { const int row = r4 + (lane >> 4);
                const f32x4 v = *(const GAS f32x4*)(SSQ + (size_t)row * 64 + (lane & 15) * 4); float s = (v.x + v.y) + (v.z + v.w);
                s += __shfl_xor(s, 1); s += __shfl_xor(s, 2); s += __shfl_xor(s, 4); s += __shfl_xor(s, 8);
                if ((lane & 15) == 0) RSTD[row] = 1.0f / sqrtf(s * (1.0f / DM) + EPS); }
        } else {
            for (int row = gw; row < MFULL; row += NGW) { if (row % SEQL < NMETA) continue; h_row<2>(nullptr, HB, row, false, slab, RSTD, g, out, lane); }
        }
    }
}
__device__ __forceinline__ void p0_prologue(Frame& F, const float* const* in, unsigned char* ws) {
    LAS float* scr = (LAS float*)(F.lds + RING_OFF + F.wave * 16384);
    const int gw = F.vcu * NWAVES + F.wave, NGW = F.G * NWAVES;
    const float *w_in = in[3], *w_uq = in[6], *w_ukv = in[7], *w_o = in[10];
    bf16* Win_t = (bf16*)(ws + WS_WIN); bf16* Wuq_t = (bf16*)(ws + WS_WUQ); bf16* Wukv_t = (bf16*)(ws + WS_WUKV); bf16* Wo_t = (bf16*)(ws + WS_WO);
    constexpr int C_IN = 64 * 370, C_UQ = 16 * 96, C_UKV = 8 * 128, C_WO = 64 * 128, C_L = C_IN + C_UQ + C_UKV + C_WO;
    for (int it = gw; it < DEPTH * C_L; it += NGW) {
        const int l = it / C_L; int r = it % C_L;
        if (r < C_IN) { const int kb = r / 370, sb = r % 370, src = 32 * sb; const int dst = src < 1536 ? src : (src == 1536 ? 1536 : (src == 1568 ? 1664 : src + 192));
            transpose_item(w_in + (size_t)l * DM * DIN, DIN, DM, Win_t + (size_t)l * NIN * DM, src, dst, 64 * kb, scr, F.lane, in[2] + (size_t)l * DM); continue; }
        r -= C_IN;
        if (r < C_UQ) { const int kb = r / 96, sb = r % 96, hd = sb / 6, jb = sb % 6; const int dst = jb < 4 ? hd * 128 + jb * 32 : (8 + hd / 4) * 256 + (jb - 4) * 128 + (hd % 4) * 32;
            transpose_item(w_uq + (size_t)l * QL * NUQ, NUQ, QL, Wuq_t + (size_t)l * NUQ * QL, 32 * sb, dst, 64 * kb, scr, F.lane, in[4] + (size_t)l * QL); continue; }
        r -= C_UQ;
        if (r < C_UKV) { const int kb = r / 128, sb = r % 128, hd = sb / 8, jb = sb % 8; const int dst = jb < 4 ? hd * 128 + jb * 32 : 2048 + hd * 128 + (jb - 4) * 32;
            transpose_item(w_ukv + (size_t)l * KVL * NUKV, NUKV, KVL, Wukv_t + (size_t)l * NUKV * KVL, 32 * sb, dst, 64 * kb, scr, F.lane, in[5] + (size_t)l * KVL); continue; }
        r -= C_UKV;
        { const int kb = r / 128, sb = r % 128; transpose_item(w_o + (size_t)l * DM * DM, DM, DM, Wo_t + (size_t)l * DM * DM, 32 * sb, 32 * sb, 64 * kb, scr, F.lane, kb < 32 ? in[8] + (size_t)l * 2048 : in[9] + (size_t)l * 2048 - 2048); }
    }
    const int gtid = F.vcu * (NWAVES * 64) + F.tid, NT = F.G * NWAVES * 64;
    for (int idx = gtid; idx < DEPTH * 192 * 512; idx += NT) {
        const int l = idx / (192 * 512), r = idx % (192 * 512), row = r / 512, c16 = r % 512, drow = row < 96 ? 1568 + row : 1696 + (row - 96);
        *(GAS v4u*)(Win_t + ((size_t)l * NIN + drow) * DM + c16 * 8) = (v4u){0u, 0u, 0u, 0u}; }
    for (int idx = gtid; idx < (MP - M) * 512; idx += NT) *(GAS v4u*)((bf16*)(ws + WS_A) + (size_t)M * 4096 + (size_t)idx * 8) = (v4u){0u, 0u, 0u, 0u};
    float* rope = (float*)(ws + WS_ROPE);
    for (int idx = gtid; idx < SEQL * 32; idx += NT) { const int pos = idx >> 5, i = idx & 31;
        const float inv = powf(10000.0f, -(float)(2 * i) / 64.0f), ang = (float)pos * inv;
        rope[pos * 64 + i] = cosf(ang); rope[pos * 64 + 32 + i] = sinf(ang); }
    h_rows<0>(F, in[0], in[1], (bf16*)(ws + WS_U), nullptr, nullptr, (float*)(ws + WS_RSTD), nullptr, nullptr);
}

struct Args { const float* in[12]; float* out; unsigned char* ws; int ph_lo, ph_hi; };
constexpr int NPH = 1 + 7 * DEPTH;
__global__ void __launch_bounds__(NWAVES * 64, 2) hymba_fwd(Args args) {
    extern __shared__ __attribute__((aligned(16))) unsigned char lds[];
    Frame F;
    F.lds = (LAS unsigned char*)lds;
    F.MISC = (volatile LAS unsigned*)(F.lds + MISC_OFF);
    F.tid = threadIdx.x; F.lane = F.tid & 63; F.wave = __builtin_amdgcn_readfirstlane(F.tid >> 6);
    F.G = gridDim.x; { const int bx = blockIdx.x; F.vcu = (F.G % 8 == 0) ? (bx % 8) * (F.G / 8) + bx / 8 : bx; }
    unsigned char* ws = args.ws;
    F.ctl = (gu32*)(ws + WS_CTL);
    for (int u = F.tid; u < (LDS_BYTES - LDSCTL_OFF) / 4; u += NWAVES * 64) ((LAS unsigned*)(F.lds + LDSCTL_OFF))[u] = 0u;
    __syncthreads();
    XcdBarrier bar; bar.bar = (unsigned*)(F.ctl + CW_BAR); bar.x = 0; bar.st = nullptr;
    if (!MK_MULTI) bar = xcd_barrier_post((unsigned*)(F.ctl + CW_BAR), F.MISC + 8);
    const int lo = args.ph_lo, hi = args.ph_hi;
#ifndef PHMASK
#define PHMASK 0x1ff
#endif
#define EN(t) (((PHMASK) >> (t)) & 1)
#define IN(k) (lo <= (k) && (k) < hi)
#ifndef REP_BAR
#define REP_BAR 1
#endif
#define GRID_BAR(k) do { if (IN((k) + 1)) { if (!MK_MULTI) for (int rb_ = 0; rb_ < REP_BAR; ++rb_) xcd_barrier(bar); } } while (0)
#define WSL_() GAS unsigned char* wsl = (GAS unsigned char*)ws; asm volatile("" : "+s"(wsl))
#define U ((bf16*)(wsl + WS_U))
#define SSQ ((float*)(wsl + WS_SSQ))
#define RSTD ((float*)(wsl + WS_RSTD))
#define SSQY ((float*)(wsl + WS_SSQY))
#define RATIO ((float*)(wsl + WS_RATIO))
#define RSB ((float*)(wsl + WS_RSB))
#define SSQQ ((float*)(wsl + WS_SSQQ))
#define SSQKV ((float*)(wsl + WS_SSQKV))
#define CQN ((bf16*)(wsl + WS_CQN))
#define CKVN ((bf16*)(wsl + WS_CKVN))
#define KR ((bf16*)(wsl + WS_KR))
#define Zb ((bf16*)(wsl + WS_Z))
#define QSB ((bf16*)(wsl + WS_QSB))
#define KSB ((bf16*)(wsl + WS_KSB))
#define VSB ((bf16*)(wsl + WS_VSB))
#define QM ((bf16*)(wsl + WS_QM))
#define KM ((bf16*)(wsl + WS_KM))
#define VM ((bf16*)(wsl + WS_VM))
#define A ((bf16*)(wsl + WS_A))
#define rope ((const float*)(wsl + WS_ROPE))

    #ifndef REP_THIN
#define REP_THIN 1
#endif
    if (EN(0) && IN(0)) { for (int rep = 0; rep < REP_THIN; ++rep) p0_prologue(F, args.in, ws); GRID_BAR(0); }
    for (int l = 0; l < DEPTH; ++l) {
        const int pb = 1 + 7 * l;
        if (EN(1) && IN(pb)) {
            WSL_();
            pg8::Gemm g{U, (const bf16*)(wsl + WS_WIN) + (size_t)l * NIN * DM, MP, NIN, DM}; pg8::InAOrder S{F.G, (int)blockIdx.x};
            pg8::EpiIn E{CQN, CKVN, SSQQ, SSQKV, KR, Zb, QSB, KSB, VSB, rope, RSTD};
            pg8::gemm_phase<pg8::EpiIn, pg8::InAOrder, true, true>(F.lds + RING_OFF, g, S, E);
            GRID_BAR(pb);
        }
        if (EN(3) && IN(pb + 2)) {
            WSL_();
            { pg8::Gemm g{U, (const bf16*)(wsl + WS_WIN) + (size_t)l * NIN * DM, MP, NIN, DM}; pg8::InBOrder S{F.G, (int)blockIdx.x};
              pg8::EpiIn E{CQN, CKVN, SSQQ, SSQKV, KR, Zb, QSB, KSB, VSB, rope, RSTD};
              pg8::gemm_phase<pg8::EpiIn, pg8::InBOrder, true, true>(F.lds + RING_OFF, g, S, E); }
            { pg8::Gemm g{CQN, (const bf16*)(wsl + WS_WUQ) + (size_t)l * NUQ * QL, MP, NUQ, QL}; pg8::StaticOrder S; S.init(MP, NUQ, F.G, (int)(F.G - 1 - blockIdx.x));
              pg8::EpiUq E{QM, rope, SSQQ};
              pg8::gemm_phase<pg8::EpiUq, pg8::StaticOrder, true, true>(F.lds + RING_OFF, g, S, E); }
            { pg8::Gemm g{CKVN, (const bf16*)(wsl + WS_WUKV) + (size_t)l * NUKV * KVL, MP, NUKV, KVL}; pg8::StaticOrder S; S.init(MP, NUKV, F.G, (int)(F.G - 1 - blockIdx.x));
              pg8::EpiUkv E{KM, VM, SSQKV};
              pg8::gemm_phase<pg8::EpiUkv, pg8::StaticOrder, true, true>(F.lds + RING_OFF, g, S, E); }
            GRID_BAR(pb + 2);
        }
        if (IN(pb + 3)) {
            WSL_(); char* al = (char*)lds + RING_OFF;
            const int npair = (512 - F.vcu + F.G - 1) / F.G;
            const int m0a = F.vcu, m0b = (F.vcu + F.G - 64 % F.G) % F.G;
            const int nmeta_a = m0a < 64 ? (63 - m0a) / F.G + 1 : 0, nmeta_b = m0b < 64 ? (63 - m0b) / F.G + 1 : 0;
#ifndef REP_MLA
#define REP_MLA 1
#endif
            if (EN(4)) for (int rep = 0; rep < REP_MLA; ++rep) {
#pragma clang loop unroll(disable)
                for (int j = 0; j < 2 * npair + nmeta_a; ++j) {
                    int bh, qb;
                    if (j < 2 * npair) { const int item = F.vcu + F.G * (j >> 1), p = item & 7; bh = item >> 3; qb = (j & 1) ? 1 + p : 16 - p; }
                    else { bh = m0a + F.G * (j - 2 * npair); qb = 0; }
                    const size_t row0 = (size_t)(bh >> 4) * SEQL; const int hd = bh & 15;
                    att::mla_block(QM + row0 * 3072 + hd * 192, KM + row0 * 2048 + hd * 128, KR + row0 * 64, VM + row0 * 2048 + hd * 128, A + row0 * 4096 + hd * 128, Zb + row0 * 4096 + hd * 128, SSQY + row0 * 32 + hd, qb, al);
                }
            }
#ifndef REP_SB
#define REP_SB 1
#endif
            if (EN(5)) {
#pragma clang loop unroll(disable)
                for (int j = 0; ; ++j) {
                    int item = F.vcu + F.G * j; bool meta = false;
                    if (item >= 1024) { const int nreg = (1024 - F.vcu + F.G - 1) / F.G;
                        const int m = (F.vcu + F.G - 64 % F.G) % F.G + F.G * (j - nreg); if (m >= 32) break; item = m; meta = true; }
                    const int bhA = meta ? 2 * item : item >> 4, bhB = meta ? 2 * item + 1 : bhA, hbA = meta ? 0 : 2 * (item & 15) + 1, hbB = meta ? 0 : hbA + 1;
                    const size_t rA = (size_t)(bhA >> 4) * SEQL, rB = (size_t)(bhB >> 4) * SEQL; const int hA = bhA & 15, hB = bhB & 15;
                    const att::SbHalf HA{QSB + rA * 2048 + hA * 128, KSB + rA * 2048 + hA * 128, VSB + rA * 2048 + hA * 128, Zb + rA * 4096 + 2048 + hA * 128, A + rA * 4096 + 2048 + hA * 128, SSQY + rA * 32 + 16 + hA, hbA};
                    const att::SbHalf HB{QSB + rB * 2048 + hB * 128, KSB + rB * 2048 + hB * 128, VSB + rB * 2048 + hB * 128, Zb + rB * 4096 + 2048 + hB * 128, A + rB * 4096 + 2048 + hB * 128, SSQY + rB * 32 + 16 + hB, hbB};
                    att::sb_block2(HA, HB, al);
                }
            }
            GRID_BAR(pb + 3);
        }
        if (EN(7) && IN(pb + 5)) {
            WSL_();
            LAS float* ytab = (LAS float*)(F.lds + LDSCTL_OFF + 1024);
#define FILL_YTAB(pm_) do { int t0_ = F.tid; asm volatile("" : "+v"(t0_)); for (int r_ = t0_; r_ < 256; r_ += NWAVES * 64) { const int row_ = (pm_) * 256 + r_; float ra_ = 0.f, rb_ = 0.f;                                  \
                if (row_ < M) { const GAS f32x4* sp_ = (const GAS f32x4*)(SSQY + (size_t)row_ * 32); float s1_ = 0.f, s2_ = 0.f;                                                  \
                    _Pragma("unroll") for (int j_ = 0; j_ < 4; ++j_) { const f32x4 a_ = sp_[j_], b_ = sp_[4 + j_]; s1_ += (a_.x + a_.y) + (a_.z + a_.w); s2_ += (b_.x + b_.y) + (b_.z + b_.w); } \
                    const float r1_ = 1.0f / sqrtf(s1_ * (1.0f / 2048) + EPS), r2_ = 1.0f / sqrtf(s2_ * (1.0f / 2048) + EPS); ra_ = r1_ / r2_; rb_ = r2_; }                     \
                ytab[r_] = ra_; ytab[256 + r_] = rb_; } __syncthreads(); } while (0)
            { pg8::Gemm g{A, (const bf16*)(wsl + WS_WO) + (size_t)l * DM * DM, 16384, DM, DM, DM}; pg8::StaticOrder S; S.init(16384, DM, F.G, (int)blockIdx.x);
              { pg8::Unit u0; if (S.next(0, u0)) FILL_YTAB(u0.pm); else __syncthreads(); }
              pg8::EpiResBf E{U, SSQ, (const LAS float*)ytab};
              pg8::gemm_phase<pg8::EpiResBf, pg8::StaticOrder, true, true>(F.lds + RING_OFF, g, S, E); }
#if defined(REP_OUT)
#endif
            { pg8::Gemm g{A, (const bf16*)(wsl + WS_WO) + (size_t)l * DM * DM, MP, DM, 256, DM}; pg8::SplitKOrder S{64, 16, 16, 256, F.G, (int)blockIdx.x};
              FILL_YTAB(64);
              pg8::EpiSlab E{(float*)(wsl + WS_SLAB), 256, (const LAS float*)ytab};
              pg8::gemm_phase<pg8::EpiSlab, pg8::SplitKOrder, true, true>(F.lds + RING_OFF, g, S, E); }
#undef FILL_YTAB
            GRID_BAR(pb + 5);
        }
        if (EN(8) && IN(pb + 6)) {
            WSL_();
            if (l + 1 < DEPTH) { h_rows<1>(F, nullptr, nullptr, U, (const float*)(wsl + WS_SLAB), SSQ, RSTD, nullptr, nullptr); GRID_BAR(pb + 6); }
            else h_rows<2>(F, nullptr, nullptr, U, (const float*)(wsl + WS_SLAB), SSQ, RSTD, args.in[11], args.out);
        }
    }
#undef IN
#undef GRID_BAR
#undef WSL_
#undef U
#undef SSQ
#undef RSTD
#undef SSQY
#undef RATIO
#undef RSB
#undef SSQQ
#undef SSQKV
#undef CQN
#undef CKVN
#undef KR
#undef Zb
#undef QSB
#undef KSB
#undef VSB
#undef QM
#undef KM
#undef VM
#undef A
#undef rope
}

extern "C" void kernel_launch(void* const* d_in, const int* in_sizes, int n_in, void* d_out, int out_size, void* d_ws, size_t ws_size, hipStream_t stream) {
    static int grid = 0;
    if (grid == 0) {
        if (n_in != 12 || in_sizes[0] != BATCH * SEQ * DM || out_size != BATCH * SEQ * DM || ws_size < WS_END) {
            fprintf(stderr, "kernel_launch: shape/workspace mismatch (n_in %d, in0 %d, out %d, ws %zu, need %zu); nothing launched\n", n_in, n_in > 0 ? in_sizes[0] : -1, out_size, ws_size, (size_t)WS_END); grid = -1; return; }
        int dev = 0, cus = 0, per_cu = 0;
        if (hipGetDevice(&dev) != hipSuccess || hipDeviceGetAttribute(&cus, hipDeviceAttributeMultiprocessorCount, dev) != hipSuccess) { grid = -1; return; }
        if (hipFuncSetAttribute((const void*)hymba_fwd, hipFuncAttributeMaxDynamicSharedMemorySize, LDS_BYTES) != hipSuccess) { fprintf(stderr, "kernel_launch: hipFuncSetAttribute failed\n"); grid = -1; return; }
        if (hipOccupancyMaxActiveBlocksPerMultiprocessor(&per_cu, (const void*)hymba_fwd, NWAVES * 64, LDS_BYTES) != hipSuccess || per_cu < 1)
            fprintf(stderr, "kernel_launch: note: occupancy query reports %d workgroups per CU\n", per_cu);
        (void)hipGetLastError();
        grid = cus;
    }
    if (grid < 0) return;
    if (hipMemsetAsync((char*)d_ws + WS_CTL, 0, CTL_ZERO_BYTES, stream) != hipSuccess) return;
    Args a{};
    for (int i = 0; i < 12; ++i) a.in[i] = (const float*)d_in[i];
    a.out = (float*)d_out; a.ws = (unsigned char*)d_ws;
#if MK_MULTI
    for (int ph = 0; ph < NPH; ++ph) { a.ph_lo = ph; a.ph_hi = ph + 1; hipLaunchKernelGGL(hymba_fwd, dim3(grid), dim3(NWAVES * 64), LDS_BYTES, stream, a); }
#else
    a.ph_lo = 0; a.ph_hi = NPH;
    hipLaunchKernelGGL(hymba_fwd, dim3(grid), dim3(NWAVES * 64), LDS_BYTES, stream, a);
#endif
    const hipError_t le = hipPeekAtLastError();
    if (le != hipSuccess) fprintf(stderr, "kernel_launch: launch failed: %s\n", hipGetErrorName(le));
}
```

```cpp
#include <hip/hip_runtime.h>
#include <hip/hip_bf16.h>
#include <cstdio>
#include <cstdint>
#include <cmath>
namespace pg8 {
#define PG8_LAS __attribute__((address_space(3)))
typedef unsigned short bf16_t;
typedef short bf16x8 __attribute__((ext_vector_type(8)));
typedef float f32x4 __attribute__((ext_vector_type(4)));
typedef unsigned u32x4 __attribute__((ext_vector_type(4)));
constexpr int BM = 256, BK = 64, HALF = 128, HTB = HALF * BK * 2  , STAGE_BYTES = 8 * HTB, NXCD = 8, WGM = 8;

__host__ __device__ __forceinline__ int lds_byte(int r, int c) { const int st = (r >> 4) * 2 + (c >> 5), rr = r & 15, cc = c & 31, ob = rr * 64 + cc * 2; return st * 1024 + (ob ^ (((ob >> 9) & 1) << 5)); }
__host__ __device__ __forceinline__ void stage_rc(int b, int& R, int& C) { const int st = b / 1024, sb = b % 1024, swz = sb ^ (((sb >> 9) & 1) << 5); R = (st >> 1) * 16 + swz / 64; C = (st & 1) * 32 + (swz % 64) / 2; }
__host__ __device__ __forceinline__ int perm32(int rho) { const int n = rho >> 4, i = rho & 15; return 8 * (i >> 2) + 4 * n + (i & 3); }

struct Unit { int pm, pn, koff; };
struct Gemm { const bf16_t* A; const bf16_t* Bt; int M, N, K, ld; };

struct StaticOrder {
    int nM, nN, nwg, G, c;
    __host__ __device__ void init(int M, int N, int G_, int c_) { nM = M / BM; nN = N / BM; nwg = nM * nN; G = G_; c = c_; }
    __host__ __device__ __forceinline__ bool next(int i, Unit& u) const {
        const long L = (long)i * G + c; if (L >= nwg) return false;
        int wgid = (int)L; { const int q = nwg / NXCD, r = nwg % NXCD, xcd = wgid % NXCD, off = wgid / NXCD; wgid = (xcd < r ? xcd * (q + 1) : r * (q + 1) + (xcd - r) * q) + off; }
        const int nig = WGM * nN, gid = wgid / nig, fm = gid * WGM, gsz = (nM - fm) < WGM ? (nM - fm) : WGM;
        u.pm = fm + ((wgid % nig) % gsz); u.pn = (wgid % nig) / gsz; u.koff = 0; return true;
    }
    __device__ __forceinline__ void a_ready(const Unit&) const {}
    __device__ __forceinline__ void done(const Unit&) const {}
};
struct InAOrder {
    int G, c;
    __host__ __device__ __forceinline__ bool next(int i, Unit& u) const {
        const int L = i * G + c; if (L >= 512) return false;
        const int x = L & 7, j = L >> 3;
        if (x < 7) { u.pm = 8 * x + (j & 7); u.pn = j >> 3; }
        else if (j < 54) { u.pm = 56 + j % 9; u.pn = j / 9; }
        else { const int jj = j - 54; u.pm = 56 + jj % 5; u.pn = 6 + jj / 5; }
        u.koff = 0; return true;
    }
    __device__ __forceinline__ void a_ready(const Unit&) const {}
    __device__ __forceinline__ void done(const Unit&) const {}
};
struct InBOrder {
    int G, c;
    __host__ __device__ __forceinline__ bool next(int i, Unit& u) const {
        constexpr int nM = 65, nN = 39, nwg = nM * nN;
        const int L = i * G + c; if (L >= nwg + 8) return false;
        u.koff = 0;
        if (L >= nwg) { const int k = L - nwg; u.pm = 61 + (k & 3); u.pn = 6 + (k >> 2); return true; }
        int wgid = L; { constexpr int q = nwg / NXCD, r = nwg % NXCD; const int xcd = wgid % NXCD, off = wgid / NXCD; wgid = (xcd < r ? xcd * (q + 1) : r * (q + 1) + (xcd - r) * q) + off; }
        constexpr int nig = WGM * nN; const int gid = wgid / nig, fm = gid * WGM, gsz = (nM - fm) < WGM ? (nM - fm) : WGM;
        u.pm = fm + ((wgid % nig) % gsz); u.pn = 8 + (wgid % nig) / gsz; return true;
    }
    __device__ __forceinline__ void a_ready(const Unit&) const {}
    __device__ __forceinline__ void done(const Unit&) const {}
};
struct DynOrder {
    __attribute__((address_space(1))) unsigned* ctr; volatile PG8_LAS unsigned* slot; int nM, nN, nwg, nstat, G, c;
    __device__ __forceinline__ bool next(int i, Unit& u) const {
        int L;
        if (i < nstat) L = i * G + c;
        else {
            int t_ = threadIdx.x; asm volatile("" : "+v"(t_));
            if (t_ == 0) { const unsigned v = __hip_atomic_fetch_add(ctr, 1u, __ATOMIC_RELAXED, __HIP_MEMORY_SCOPE_AGENT); slot[i & 1] = (unsigned)(nstat * G) + v; }
            asm volatile("s_waitcnt lgkmcnt(0)" ::: "memory"); __builtin_amdgcn_s_barrier(); asm volatile("" ::: "memory");
            L = __builtin_amdgcn_readfirstlane((int)slot[i & 1]);
        }
        if (L >= nwg) return false;
        const int nig = WGM * nN, gid = L / nig, fm = gid * WGM, gsz = (nM - fm) < WGM ? (nM - fm) : WGM;
        u.pm = fm + ((L % nig) % gsz); u.pn = (L % nig) / gsz; u.koff = 0; return true;
    }
    __device__ __forceinline__ void a_ready(const Unit&) const {}
    __device__ __forceinline__ void done(const Unit&) const {}
};
struct SplitKOrder {
    int pm, nN, nS, kslice, G, c;
    __host__ __device__ __forceinline__ bool next(int i, Unit& u) const { const int L = i * G + c; if (L >= nN * nS) return false; u.pm = pm; u.pn = L % nN; u.koff = (L / nN) * kslice; return true; }
    __device__ __forceinline__ void a_ready(const Unit&) const {}
    __device__ __forceinline__ void done(const Unit&) const {}
};

__device__ __forceinline__ unsigned cvt_pk_bf16(float lo, float hi) { unsigned r; asm volatile("v_cvt_pk_bf16_f32 %0, %1, %2" : "=v"(r) : "v"(lo), "v"(hi)); return r; }
typedef float f32x2 __attribute__((ext_vector_type(2)));

constexpr int SEQL = 4112;
__device__ __forceinline__ void st8_bf16(bf16_t* p, f32x4 v0, f32x4 v1) {
    u32x4 w; w.x = cvt_pk_bf16(v0[0], v0[1]); w.y = cvt_pk_bf16(v0[2], v0[3]); w.z = cvt_pk_bf16(v1[0], v1[1]); w.w = cvt_pk_bf16(v1[2], v1[3]);
    *(u32x4*)p = w;
}
__device__ __forceinline__ float bf_lo(unsigned w) { return __builtin_bit_cast(float, w << 16); }
__device__ __forceinline__ float bf_hi(unsigned w) { return __builtin_bit_cast(float, w & 0xffff0000u); }
__device__ __forceinline__ float st8_bf16_ss(bf16_t* p, f32x4 v0, f32x4 v1) {
    u32x4 w; w.x = cvt_pk_bf16(v0[0], v0[1]); w.y = cvt_pk_bf16(v0[2], v0[3]); w.z = cvt_pk_bf16(v1[0], v1[1]); w.w = cvt_pk_bf16(v1[2], v1[3]);
    *(u32x4*)p = w; float ss = 0.f;
#pragma unroll
    for (int e = 0; e < 4; ++e) { const float x = bf_lo(w[e]), y = bf_hi(w[e]); ss += x * x + y * y; }
    return ss;
}
__device__ __forceinline__ void rope8(const float* tab, f32x4 x1a, f32x4 x1b, f32x4 x2a, f32x4 x2b, bf16_t* o1, bf16_t* o2) {
    const f32x4 c0 = *(const f32x4*)tab, c1 = *(const f32x4*)(tab + 4), s0 = *(const f32x4*)(tab + 32), s1 = *(const f32x4*)(tab + 36);
    st8_bf16(o1, x1a * c0 - x2a * s0, x1b * c1 - x2b * s1);
    st8_bf16(o2, x2a * c0 + x1a * s0, x2b * c1 + x1b * s1);
}
struct EpiIn {
    static constexpr bool PERM = true, AFTER_DRAIN = false, MID = false, PRE = true;
    bf16_t* CQN; bf16_t* CKVN; float* SSQQ; float* SSQKV; bf16_t* KR; bf16_t* Z; bf16_t* QSB; bf16_t* KSB; bf16_t* VSB; const float* rope; const float* rstd;
    __device__ __forceinline__ void pre(float (&p)[4], const Unit& u, int wr, int wc, int fr, int fq) const {
        const int row = u.pm * BM + wr * 64 + fr + (fq >> 1) * HALF + (fq & 1) * 32;
        p[0] = rstd[row]; p[1] = rstd[row + 16];
    }
    __device__ __forceinline__ void epi(const f32x4 (&acc)[2][2][4][2], const Unit& u, int wr, int wc, int fr, int fq, const float (&p)[4]) const {
        const int pn = u.pn, row0 = u.pm * BM + wr * 64 + fr, cin = wc * 32 + 8 * fq;
        float rs[2][4];
#pragma unroll
        for (int ai = 0; ai < 2; ++ai)
#pragma unroll
            for (int m = 0; m < 4; ++m) rs[ai][m] = __shfl(p[m & 1], fr + 16 * (2 * ai + (m >> 1)));
        if (pn < 6) {
            bf16_t* base; float* sq; int ldc, col, nsl, sl;
            if (pn < 4) { base = CQN; ldc = 1024; col = pn * 256; sq = SSQQ; nsl = 16; sl = 4 * pn + wc; } else { base = CKVN; ldc = 512; col = (pn - 4) * 256; sq = SSQKV; nsl = 8; sl = 4 * (pn - 4) + wc; }
#pragma unroll
            for (int ai = 0; ai < 2; ++ai)
#pragma unroll
                for (int m = 0; m < 4; ++m) { const int row = row0 + ai * HALF + m * 16; bf16_t* rowp = base + (size_t)row * ldc + col + cin; float ss = 0.f;
#pragma unroll
                    for (int bj = 0; bj < 2; ++bj) ss += st8_bf16_ss(rowp + bj * HALF, acc[ai][bj][m][0] * rs[ai][m], acc[ai][bj][m][1] * rs[ai][m]);
                    ss += __shfl_xor(ss, 16); ss += __shfl_xor(ss, 32);
                    if (fq == 0) sq[(size_t)row * nsl + sl] = ss; }
        } else if (pn == 6) {
            if (wc == 0) {
#pragma unroll
                for (int ai = 0; ai < 2; ++ai)
#pragma unroll
                    for (int m = 0; m < 4; ++m) { const int row = row0 + ai * HALF + m * 16, pos = row % SEQL;
                        bf16_t* o = KR + (size_t)row * 64 + 8 * fq;
                        rope8(rope + pos * 64 + 8 * fq, acc[ai][0][m][0] * rs[ai][m], acc[ai][0][m][1] * rs[ai][m], acc[ai][1][m][0] * rs[ai][m], acc[ai][1][m][1] * rs[ai][m], o, o + 32); }
            }
        } else {
            bf16_t* base; int ldc, col; float qs = 1.f;
            if (pn < 15) { base = Z; ldc = 4096; col = (pn - 7) * 256; }
            else if (pn < 23) { base = QSB; ldc = 2048; col = (pn - 15) * 256; qs = -0.12751743f; }
            else if (pn < 31) { base = KSB; ldc = 2048; col = (pn - 23) * 256; }
            else if (pn < 39) { base = VSB; ldc = 2048; col = (pn - 31) * 256; }
            else { base = Z; ldc = 4096; col = 2048 + (pn - 39) * 256; }
#pragma unroll
            for (int ai = 0; ai < 2; ++ai)
#pragma unroll
                for (int m = 0; m < 4; ++m) { bf16_t* rowp = base + (size_t)(row0 + ai * HALF + m * 16) * ldc + col + cin;
#pragma unroll
                    for (int bj = 0; bj < 2; ++bj) st8_bf16(rowp + bj * HALF, acc[ai][bj][m][0] * (rs[ai][m] * qs), acc[ai][bj][m][1] * (rs[ai][m] * qs)); }
        }
    }
};
struct EpiUq {
    static constexpr bool PERM = true, AFTER_DRAIN = false, MID = false, PRE = true;
    bf16_t* QM; const float* rope; const float* SSQQ;
    __device__ __forceinline__ void pre(float (&p)[4], const Unit& u, int wr, int wc, int fr, int fq) const {
        const int row = u.pm * BM + wr * 64 + fr + (fq >> 1) * HALF + (fq & 1) * 32;
#pragma unroll
        for (int j = 0; j < 2; ++j) { const f32x4* sp = (const f32x4*)(SSQQ + (size_t)(row + 16 * j) * 16); const f32x4 a = sp[0], b = sp[1], c = sp[2], d = sp[3];
            const float s = ((a[0] + a[1]) + (a[2] + a[3])) + ((b[0] + b[1]) + (b[2] + b[3])) + ((c[0] + c[1]) + (c[2] + c[3])) + ((d[0] + d[1]) + (d[2] + d[3]));
            p[j] = 1.0f / sqrtf(s * (1.0f / 1024.0f) + 1e-6f); }
    }
    __device__ __forceinline__ void epi(const f32x4 (&acc)[2][2][4][2], const Unit& u, int wr, int wc, int fr, int fq, const float (&p)[4]) const {
        const int pn = u.pn, row0 = u.pm * BM + wr * 64 + fr, cin = wc * 32 + 8 * fq;
#define RSQ_(ai, m) (__shfl(p[(m) & 1], fr + 16 * (2 * (ai) + ((m) >> 1))) * 0.10411754f)
        if (pn < 8) {
#pragma unroll
            for (int ai = 0; ai < 2; ++ai)
#pragma unroll
                for (int m = 0; m < 4; ++m) { bf16_t* rowp = QM + (size_t)(row0 + ai * HALF + m * 16) * 3072 + cin; const float r_ = RSQ_(ai, m);
#pragma unroll
                    for (int bj = 0; bj < 2; ++bj) st8_bf16(rowp + (2 * pn + bj) * 192, acc[ai][bj][m][0] * r_, acc[ai][bj][m][1] * r_); }
        } else {
            const int head = 4 * (pn - 8) + wc;
#pragma unroll
            for (int ai = 0; ai < 2; ++ai)
#pragma unroll
                for (int m = 0; m < 4; ++m) { const int row = row0 + ai * HALF + m * 16, pos = row % SEQL; const float r_ = RSQ_(ai, m);
                    bf16_t* o = QM + (size_t)row * 3072 + head * 192 + 128 + 8 * fq;
                    rope8(rope + pos * 64 + 8 * fq, acc[ai][0][m][0] * r_, acc[ai][0][m][1] * r_, acc[ai][1][m][0] * r_, acc[ai][1][m][1] * r_, o, o + 32); }
        }
#undef RSQ_
    }
};
struct EpiUkv {
    static constexpr bool PERM = true, AFTER_DRAIN = false, MID = false, PRE = true;
    bf16_t* KM; bf16_t* VM; const float* SSQKV;
    __device__ __forceinline__ void pre(float (&p)[4], const Unit& u, int wr, int wc, int fr, int fq) const {
        const int row = u.pm * BM + wr * 64 + fr + (fq >> 1) * HALF + (fq & 1) * 32;
#pragma unroll
        for (int j = 0; j < 2; ++j) { const f32x4* sp = (const f32x4*)(SSQKV + (size_t)(row + 16 * j) * 8); const f32x4 a = sp[0], b = sp[1];
            const float s = ((a[0] + a[1]) + (a[2] + a[3])) + ((b[0] + b[1]) + (b[2] + b[3]));
            p[j] = 1.0f / sqrtf(s * (1.0f / 512.0f) + 1e-6f); }
    }
    __device__ __forceinline__ void epi(const f32x4 (&acc)[2][2][4][2], const Unit& u, int wr, int wc, int fr, int fq, const float (&p)[4]) const {
        const int pn = u.pn, row0 = u.pm * BM + wr * 64 + fr, cin = wc * 32 + 8 * fq;

        bf16_t* base = pn < 8 ? KM : VM; const int col = (pn & 7) * 256;
#pragma unroll
        for (int ai = 0; ai < 2; ++ai)
#pragma unroll
            for (int m = 0; m < 4; ++m) { bf16_t* rowp = base + (size_t)(row0 + ai * HALF + m * 16) * 2048 + col + cin;
                const float r_ = __shfl(p[m & 1], fr + 16 * (2 * ai + (m >> 1)));
#pragma unroll
                for (int bj = 0; bj < 2; ++bj) st8_bf16(rowp + bj * HALF, acc[ai][bj][m][0] * r_, acc[ai][bj][m][1] * r_); }
    }
};
struct EpiResBf {
    static constexpr bool PERM = true, AFTER_DRAIN = false, MID = true, PRE = false;
    bf16_t* HB; float* SSQ; const PG8_LAS float* tab;
    __device__ __forceinline__ void mid(f32x4 (&acc)[2][2][4][2], const Unit& u, int wr, int wc, int fr, int fq) const {
        const int row0 = wr * 64 + fr; float f[2][4];
#pragma unroll
        for (int ai = 0; ai < 2; ++ai)
#pragma unroll
            for (int m = 0; m < 4; ++m) f[ai][m] = tab[row0 + ai * HALF + m * 16];
#pragma unroll
        for (int ai = 0; ai < 2; ++ai)
#pragma unroll
            for (int bj = 0; bj < 2; ++bj)
#pragma unroll
                for (int m = 0; m < 4; ++m)
#pragma unroll
                    for (int n = 0; n < 2; ++n) acc[ai][bj][m][n] *= f[ai][m];
    }
    __device__ __forceinline__ void operator()(const f32x4 (&acc)[2][2][4][2], const Unit& u, int wr, int wc, int fr, int fq) const {
        const int row0 = u.pm * BM + wr * 64 + fr, col0 = u.pn * BM + wc * 32 + 8 * fq;
#pragma unroll
        for (int ai = 0; ai < 2; ++ai) {
            u32x4 hv[4][2]; float rsbv[4];
#pragma unroll
            for (int m = 0; m < 4; ++m) { rsbv[m] = tab[256 + wr * 64 + fr + ai * HALF + m * 16];
#pragma unroll
                for (int bj = 0; bj < 2; ++bj) hv[m][bj] = *(const u32x4*)(HB + (size_t)(row0 + ai * HALF + m * 16) * 4096 + col0 + bj * HALF); }
#pragma unroll
            for (int m = 0; m < 4; ++m) { const int row = row0 + ai * HALF + m * 16; float ss = 0.f; const float rsb = rsbv[m];
#pragma unroll
                for (int bj = 0; bj < 2; ++bj) { const u32x4 h = hv[m][bj]; const f32x4 a0 = acc[ai][bj][m][0] * rsb, a1 = acc[ai][bj][m][1] * rsb;
                    u32x4 w; w.x = cvt_pk_bf16(bf_lo(h.x) + a0[0], bf_hi(h.x) + a0[1]); w.y = cvt_pk_bf16(bf_lo(h.y) + a0[2], bf_hi(h.y) + a0[3]);
                    w.z = cvt_pk_bf16(bf_lo(h.z) + a1[0], bf_hi(h.z) + a1[1]); w.w = cvt_pk_bf16(bf_lo(h.w) + a1[2], bf_hi(h.w) + a1[3]);
                    *(u32x4*)(HB + (size_t)row * 4096 + col0 + bj * HALF) = w;
#pragma unroll
                    for (int e = 0; e < 4; ++e) { const float x = bf_lo(w[e]), y = bf_hi(w[e]); ss += x * x + y * y; } }
                ss += __shfl_xor(ss, 16); ss += __shfl_xor(ss, 32);
                if (fq == 0) SSQ[(size_t)row * 64 + 4 * u.pn + wc] = ss; }
            asm volatile("" ::: "memory");
        }
    }
};

struct EpiSlab {
    static constexpr bool PERM = false, AFTER_DRAIN = false, MID = false, PRE = false;
    float* slab; int kslice; const PG8_LAS float* tab;
    __device__ __forceinline__ void operator()(const f32x4 (&acc)[2][2][4][2], const Unit& u, int wr, int wc, int fr, int fq) const {
        if (wr != 0) return;
        float* base = slab + (size_t)(u.koff / kslice) * 64 * 4096 + u.pn * BM + wc * 32 + 4 * fq;
#pragma unroll
        for (int m = 0; m < 4; ++m) { float* rowp = base + (size_t)(fr + m * 16) * 4096; const int row = u.pm * BM + fr + m * 16;
            const float sc = u.koff < 2048 ? tab[fr + m * 16] * tab[256 + fr + m * 16] : tab[256 + fr + m * 16];
#pragma unroll
            for (int bj = 0; bj < 2; ++bj)
#pragma unroll
                for (int n = 0; n < 2; ++n) *(f32x4*)(rowp + bj * HALF + n * 16) = acc[0][bj][m][n] * sc; }
    }
};

template <class Epi, class Sched, bool ALIGN_EPI = false, bool SP2 = false>
__device__ __forceinline__ void gemm_phase(PG8_LAS unsigned char* lds, const Gemm g, const Sched& S, const Epi& E) {
    int tid_ = threadIdx.x; asm volatile("" : "+v"(tid_));
    const int tid = tid_, wid = __builtin_amdgcn_readfirstlane(tid >> 6), lane = tid & 63, wr = wid >> 2, wc = wid & 3, fr = lane & 15, fq = lane >> 4;
    const int K = g.K, nt = K / BK, LD = g.ld ? g.ld : g.K;
    unsigned voffA[2], voffB[2];
#pragma unroll
    for (int i = 0; i < 2; ++i) { int R, C; stage_rc(tid * 16 + i * 8192, R, C); const int Rb = Epi::PERM ? ((R & ~31) + perm32(R & 31)) : R;
        voffA[i] = (unsigned)(R * LD + C) * 2u; voffB[i] = (unsigned)(Rb * LD + C) * 2u; }
    const size_t kstep = (size_t)(BK * 2);
    const size_t hstep = (size_t)HALF * LD * 2;
    const size_t tstep = 2 * hstep;
    const unsigned ldsw = (unsigned)wid * 1024u;
    const int aoff = lds_byte(wr * 64 + fr, fq * 8), boff = lds_byte(wc * 32 + fr, fq * 8);
#define PG8_SA(b, h) (((b) * 2 + (h)) * HTB)
#define PG8_SB(b, h) ((4 + (b) * 2 + (h)) * HTB)
#define PG8_STAGE(bufoff, gbase, voff) do { _Pragma("unroll") for (int _i = 0; _i < 2; ++_i) \
        __builtin_amdgcn_global_load_lds((const unsigned*)((const char*)(gbase) + (voff)[_i]), (PG8_LAS unsigned*)(lds + (bufoff) + ldsw + _i * 8192), 16, 0, 0); } while (0)
#define PG8_LDA(dst, b, h) do { _Pragma("unroll") for (int m = 0; m < 4; ++m) _Pragma("unroll") for (int k = 0; k < 2; ++k) dst[m][k] = *(const PG8_LAS bf16x8*)(lds + PG8_SA(b, h) + aoff + m * 2048 + k * 1024); } while (0)
#define PG8_LDB(dst, b, h) do { _Pragma("unroll") for (int n = 0; n < 2; ++n) _Pragma("unroll") for (int k = 0; k < 2; ++k) dst[n][k] = *(const PG8_LAS bf16x8*)(lds + PG8_SB(b, h) + boff + n * 2048 + k * 1024); } while (0)
#define PG8_MMA(ai, bj, At, Bt) do { __builtin_amdgcn_s_setprio(1); _Pragma("unroll") for (int m = 0; m < 4; ++m) _Pragma("unroll") for (int n = 0; n < 2; ++n) _Pragma("unroll") for (int k = 0; k < 2; ++k) \
        acc[ai][bj][m][n] = __builtin_amdgcn_mfma_f32_16x16x32_bf16(Bt[n][k], At[m][k], acc[ai][bj][m][n], 0, 0, 0); __builtin_amdgcn_s_setprio(0); } while (0)
#define PG8_WAIT_V(n) asm volatile("s_waitcnt vmcnt(" #n ")" ::: "memory")
#define PG8_WAIT_L(n) asm volatile("s_waitcnt lgkmcnt(" #n ")" ::: "memory")
#define PG8_BAR __builtin_amdgcn_s_barrier()
#define PG8_SCHED __builtin_amdgcn_sched_barrier(0)
    Unit cur, nxt; int ui = 0; float epre[4];
    if (!S.next(0, cur)) return;
    f32x4 acc[2][2][4][2];
#pragma unroll
    for (int a = 0; a < 2; ++a)
#pragma unroll
        for (int b = 0; b < 2; ++b)
#pragma unroll
            for (int m = 0; m < 4; ++m)
#pragma unroll
                for (int n = 0; n < 2; ++n) acc[a][b][m][n] = (f32x4){0.f, 0.f, 0.f, 0.f};
    bf16x8 At[4][2], B0[2][2], B1[2][2];
    const char* cA = (const char*)g.A + (size_t)cur.pm * tstep + (size_t)cur.koff * 2; const char* cB = (const char*)g.Bt + (size_t)cur.pn * tstep + (size_t)cur.koff * 2;
    S.a_ready(cur);
    if constexpr (SP2) {
        PG8_STAGE(PG8_SB(0, 0), cB, voffB); PG8_STAGE(PG8_SB(0, 1), cB + hstep, voffB); PG8_STAGE(PG8_SA(0, 0), cA, voffA); PG8_STAGE(PG8_SA(0, 1), cA + hstep, voffA);
        if (wr == 1) PG8_BAR;
        PG8_WAIT_V(2); PG8_BAR;
        PG8_STAGE(PG8_SB(1, 0), cB + kstep, voffB); PG8_STAGE(PG8_SA(1, 0), cA + kstep, voffA); PG8_STAGE(PG8_SB(1, 1), cB + hstep + kstep, voffB);
        PG8_WAIT_V(6); PG8_BAR;
    } else {
        PG8_STAGE(PG8_SB(0, 0), cB, voffB); PG8_STAGE(PG8_SA(0, 0), cA, voffA); PG8_STAGE(PG8_SB(0, 1), cB + hstep, voffB); PG8_STAGE(PG8_SA(0, 1), cA + hstep, voffA);
        if (wr == 1) PG8_BAR;
        PG8_WAIT_V(4); PG8_BAR;
        PG8_STAGE(PG8_SB(1, 0), cB + kstep, voffB); PG8_STAGE(PG8_SA(1, 0), cA + kstep, voffA); PG8_STAGE(PG8_SB(1, 1), cB + hstep + kstep, voffB);
        PG8_WAIT_V(6); PG8_BAR;
    }
    for (;;) {
        const bool has_next = S.next(ui + 1, nxt);
        const char* nA = has_next ? (const char*)g.A + (size_t)nxt.pm * tstep + (size_t)nxt.koff * 2 : cA; const char* nB = has_next ? (const char*)g.Bt + (size_t)nxt.pn * tstep + (size_t)nxt.koff * 2 : cB;
        for (int t = 0; t < nt; t += 2) {
            if constexpr (Epi::PRE) { if (t == (nt >> 1) - 2) E.pre(epre, cur, wr, wc, fr, fq); }
            if constexpr (Epi::MID) { if (t == (nt >> 1)) E.mid(acc, cur, wr, wc, fr, fq); }
            const bool last = (t == nt - 2);
            const char* a1 = cA + (size_t)(t + 1) * kstep;
            const char* a2 = last ? nA : cA + (size_t)(t + 2) * kstep; const char* b2 = last ? nB : cB + (size_t)(t + 2) * kstep;
            const char* a3 = a2 + kstep; const char* b3 = b2 + kstep;
            if (last && has_next) S.a_ready(nxt);
            if constexpr (SP2) {
            PG8_LDB(B0, 0, 0); PG8_LDB(B1, 0, 1); PG8_SCHED; PG8_LDA(At, 0, 0); PG8_STAGE(PG8_SA(1, 1), a1 + hstep, voffA);
            PG8_WAIT_V(8); PG8_WAIT_L(0); PG8_BAR; PG8_MMA(0, 0, At, B0); PG8_MMA(0, 1, At, B1); PG8_BAR; PG8_SCHED;
            PG8_LDA(At, 0, 1); PG8_STAGE(PG8_SB(0, 0), b2, voffB); PG8_STAGE(PG8_SB(0, 1), b2 + hstep, voffB); PG8_STAGE(PG8_SA(0, 0), a2, voffA);
            PG8_WAIT_V(8); PG8_WAIT_L(0); PG8_BAR; PG8_MMA(1, 0, At, B0); PG8_MMA(1, 1, At, B1); PG8_BAR; PG8_SCHED;
            PG8_LDB(B0, 1, 0); PG8_LDB(B1, 1, 1); PG8_SCHED; PG8_LDA(At, 1, 0); PG8_STAGE(PG8_SA(0, 1), a2 + hstep, voffA);
            PG8_WAIT_V(8); PG8_WAIT_L(0); PG8_BAR; PG8_MMA(0, 0, At, B0); PG8_MMA(0, 1, At, B1); PG8_BAR; PG8_SCHED;
            PG8_LDA(At, 1, 1); PG8_STAGE(PG8_SB(1, 0), b3, voffB); PG8_STAGE(PG8_SB(1, 1), b3 + hstep, voffB); PG8_STAGE(PG8_SA(1, 0), a3, voffA);
            PG8_WAIT_V(8); PG8_WAIT_L(0); PG8_BAR; PG8_MMA(1, 0, At, B0); PG8_MMA(1, 1, At, B1); PG8_BAR; PG8_SCHED;
            } else {
            PG8_LDB(B0, 0, 0); PG8_SCHED; PG8_LDA(At, 0, 0); PG8_STAGE(PG8_SA(1, 1), a1 + hstep, voffA);
            PG8_WAIT_L(8); PG8_BAR; PG8_WAIT_L(0); PG8_MMA(0, 0, At, B0); PG8_BAR; PG8_SCHED;
            PG8_LDB(B1, 0, 1); PG8_STAGE(PG8_SB(0, 0), b2, voffB);
            PG8_BAR; PG8_WAIT_L(0); PG8_MMA(0, 1, At, B1); PG8_BAR;
            PG8_LDA(At, 0, 1); PG8_STAGE(PG8_SA(0, 0), a2, voffA);
            PG8_BAR; PG8_WAIT_L(0); PG8_MMA(1, 0, At, B0); PG8_BAR; PG8_SCHED;
            PG8_STAGE(PG8_SB(0, 1), b2 + hstep, voffB);
            PG8_WAIT_V(6); PG8_BAR; PG8_MMA(1, 1, At, B1); PG8_BAR;
            PG8_LDB(B0, 1, 0); PG8_SCHED; PG8_LDA(At, 1, 0); PG8_STAGE(PG8_SA(0, 1), a2 + hstep, voffA);
            PG8_WAIT_L(8); PG8_BAR; PG8_WAIT_L(0); PG8_MMA(0, 0, At, B0); PG8_BAR; PG8_SCHED;
            PG8_LDB(B1, 1, 1); PG8_STAGE(PG8_SB(1, 0), b3, voffB);
            PG8_BAR; PG8_WAIT_L(0); PG8_MMA(0, 1, At, B1); PG8_BAR;
            PG8_LDA(At, 1, 1); PG8_STAGE(PG8_SA(1, 0), a3, voffA);
            PG8_BAR; PG8_WAIT_L(0); PG8_MMA(1, 0, At, B0); PG8_BAR; PG8_SCHED;
            PG8_STAGE(PG8_SB(1, 1), b3 + hstep, voffB);
            PG8_WAIT_V(6); PG8_BAR; PG8_MMA(1, 1, At, B1); PG8_BAR;
            }
        }
        if constexpr (ALIGN_EPI) { if (wr == 0) PG8_BAR; }
        if constexpr (!Epi::AFTER_DRAIN) { if constexpr (Epi::PRE) E.epi(acc, cur, wr, wc, fr, fq, epre); else E(acc, cur, wr, wc, fr, fq); S.done(cur); }
        if (!has_next) break;
#pragma unroll
        for (int a = 0; a < 2; ++a)
#pragma unroll
            for (int b = 0; b < 2; ++b)
#pragma unroll
                for (int m = 0; m < 4; ++m)
#pragma unroll
                    for (int n = 0; n < 2; ++n) acc[a][b][m][n] = (f32x4){0.f, 0.f, 0.f, 0.f};
        cur = nxt; cA = nA; cB = nB; ++ui;
        if constexpr (ALIGN_EPI) { if (wr == 1) PG8_BAR; }
    }
    PG8_WAIT_V(0);
    if constexpr (!ALIGN_EPI) { if (wr == 0) PG8_BAR; }
    PG8_BAR;
    if constexpr (Epi::AFTER_DRAIN) { E.fused(acc, cur, wr, wc, fr, fq, lds, wid, lane); S.done(cur); }
#undef PG8_SA
#undef PG8_SB
#undef PG8_STAGE
#undef PG8_LDA
#undef PG8_LDB
#undef PG8_MMA
#undef PG8_WAIT_V
#undef PG8_WAIT_L
#undef PG8_BAR
#undef PG8_SCHED
}
}

namespace att {
typedef unsigned short bf16_t;
typedef short bf16x8 __attribute__((ext_vector_type(8)));
typedef short s16x4 __attribute__((ext_vector_type(4)));
typedef float f32x16 __attribute__((ext_vector_type(16)));
typedef float f32x4 __attribute__((ext_vector_type(4)));
typedef unsigned u32x4 __attribute__((ext_vector_type(4)));
constexpr int NW = 8, QBLK = 32, KVBLK = 64, QB = NW * QBLK;
constexpr int SHM_V = KVBLK * 128 * 2, SHM_KN = KVBLK * 128 * 2, SHM_KR = KVBLK * 64 * 2;
constexpr int OFF_V = 0, OFF_KN = 2 * SHM_V, OFF_KR = OFF_KN + 2 * SHM_KN, OFF_WS = OFF_KR + 2 * SHM_KR, OFF_QR = OFF_WS + NW * 64 * 4, ATT_LDS = OFF_QR + NW * 4096;
constexpr int kn_off(int b) { return b == 2 ? OFF_QR : OFF_KN + b * SHM_KN; }
constexpr int v_off(int b) { return b == 2 ? OFF_KR : OFF_V + b * SHM_V; }
constexpr int LDQM = 3072, LDK = 2048, LDKR = 64, LDV = 2048, LDO = 4096, LDQS = 2048;
constexpr float LOG2E = 1.4426950408889634f;
constexpr float MLA_SCALE = 0.07216878364870323f;
constexpr float SB_SCALE = 0.08838834764831845f;
constexpr unsigned WBIG = 0x40000000u;

#define KSWZ(row, colB) ((row) * 256 + ((colB) ^ (((row) & 15) << 4)))
#define KRSWZ(row, colB) ((row) * 128 + ((colB) ^ ((((row) >> 1) & 7) << 4)))
#define SBAR() __builtin_amdgcn_sched_barrier(0)
#define ATT_LAS __attribute__((address_space(3)))
__device__ __forceinline__ int v_st(int k, int c) { const int kk = (k & ~0xC) | ((k & 4) << 1) | ((k & 8) >> 1); return ((kk >> 3) * 4 + (c >> 5)) * 512 + ((kk & 7) * 32 + (c & 31)) * 2; }
__device__ __forceinline__ int v_rd_base(int lane) { return ((lane & 3) << 3) | (((lane >> 2) & 3) << 6) | (((lane >> 4) & 1) << 5) | (((lane >> 5) & 1) << 8); }
constexpr int v_rd_off(int d0, int ks, int half) { return d0 * 512 + ks * 4096 + half * 2048; }
__device__ __forceinline__ int crow(int r, int hi) { return (r & 3) + 8 * (r >> 2) + 4 * hi; }
__device__ __forceinline__ unsigned cvtpk(float lo, float hi) { unsigned r; asm volatile("v_cvt_pk_bf16_f32 %0, %1, %2" : "=v"(r) : "v"(lo), "v"(hi)); return r; }
__device__ __forceinline__ void mask_tile(f32x16& p0, f32x16& p1, int dq) {
    const float NEG = -__builtin_inff();
#pragma unroll
    for (int r = 0; r < 16; ++r) {
        const int c = (r & 3) + 8 * (r >> 2);
        if ((unsigned)(dq - c) >= WBIG) p0[r] = NEG;
        if ((unsigned)(dq - c - 32) >= WBIG) p1[r] = NEG;
    }
}
constexpr float THR = 8.f;
__device__ __forceinline__ void partialSM(f32x16& p0, f32x16& p1, float& m_reg, float& mn, float& alpha) {
    constexpr float SCALE = MLA_SCALE;
    float pmax = p0[0];
#pragma unroll
    for (int r = 1; r < 16; ++r) pmax = fmaxf(pmax, p0[r]);
#pragma unroll
    for (int r = 0; r < 16; ++r) pmax = fmaxf(pmax, p1[r]);
    { auto rr = __builtin_amdgcn_permlane32_swap(__float_as_uint(pmax), __float_as_uint(pmax), false, false);
      pmax = fmaxf(__uint_as_float(rr[0]), __uint_as_float(rr[1])); }
    constexpr float C2 = LOG2E * SCALE;
    if (__builtin_expect(__all((pmax - m_reg) * SCALE <= THR), 1)) { mn = m_reg; alpha = 1.f; }
    else { mn = fmaxf(m_reg, pmax); alpha = __builtin_amdgcn_exp2f((m_reg - mn) * C2); m_reg = mn; }
    const float mnL = -mn * C2;
#pragma unroll
    for (int r = 0; r < 16; ++r) p0[r] = fmaf(p0[r], C2, mnL);
#pragma unroll
    for (int r = 0; r < 16; ++r) p1[r] = fmaf(p1[r], C2, mnL);
#pragma unroll
    for (int r = 0; r < 16; ++r) p0[r] = __builtin_amdgcn_exp2f(p0[r]);
}
#define PK4(P, B_, OUT) do { unsigned a0 = cvtpk(P[B_+0], P[B_+1]), a1 = cvtpk(P[B_+2], P[B_+3]);                          \
        unsigned b0 = cvtpk(P[B_+4], P[B_+5]), b1 = cvtpk(P[B_+6], P[B_+7]);                                             \
        auto r0 = __builtin_amdgcn_permlane32_swap(a0, b0, false, false); auto r1 = __builtin_amdgcn_permlane32_swap(a1, b1, false, false); \
        u32x4 w = {r0[0], r1[0], r0[1], r1[1]}; OUT = *reinterpret_cast<bf16x8*>(&w); } while (0)
__device__ __forceinline__ void finishSM(f32x16& p0, f32x16& p1, float alpha, float& l_reg, bf16x8& pa0, bf16x8& pa1, bf16x8& pa2, bf16x8& pa3) {
#pragma unroll
    for (int r = 0; r < 16; ++r) p1[r] = __builtin_amdgcn_exp2f(p1[r]);
    float ps = 0;
#pragma unroll
    for (int r = 0; r < 16; ++r) ps += p0[r];
#pragma unroll
    for (int r = 0; r < 16; ++r) ps += p1[r];
    { auto rr = __builtin_amdgcn_permlane32_swap(__float_as_uint(ps), __float_as_uint(ps), false, false);
      ps = __uint_as_float(rr[0]) + __uint_as_float(rr[1]); }
    l_reg = l_reg * alpha + ps;
    PK4(p0, 0, pa0); PK4(p0, 8, pa1); PK4(p1, 0, pa2); PK4(p1, 8, pa3);
}
constexpr float THR2 = 8.f * LOG2E;
__device__ __forceinline__ float max3f(float a, float b, float c) { return __builtin_fmaxf(__builtin_fmaxf(a, b), c); }
__device__ __forceinline__ void softmax_c(f32x16& p0, f32x16& p1, bool first, float& m_ref, f32x16& negm, float& l_reg, float& alpha, bf16x8& pa0, bf16x8& pa1, bf16x8& pa2, bf16x8& pa3) {
    float a = max3f(p0[0], p0[1], p1[0]), b = max3f(p0[2], p0[3], p1[1]); a = max3f(a, p1[2], p1[3]);
#pragma unroll
    for (int r = 4; r < 16; r += 4) { a = max3f(a, p0[r], p0[r + 1]); b = max3f(b, p0[r + 2], p0[r + 3]); a = max3f(a, p1[r], p1[r + 1]); b = max3f(b, p1[r + 2], p1[r + 3]); }
    float pmax = __builtin_fmaxf(a, b);
    { auto rr = __builtin_amdgcn_permlane32_swap(__float_as_uint(pmax), __float_as_uint(pmax), false, false);
      pmax = __builtin_fmaxf(__uint_as_float(rr[0]), __uint_as_float(rr[1])); }
    alpha = 1.f;
    if (__builtin_expect(first || __any(pmax > THR2), 0)) {
        const float dl = first ? pmax : __builtin_fmaxf(pmax, 0.f); m_ref += dl;
#pragma unroll
        for (int r = 0; r < 16; ++r) { p0[r] -= dl; p1[r] -= dl; }
#pragma unroll
        for (int r = 0; r < 16; ++r) negm[r] = -m_ref;
        alpha = first ? 1.f : __builtin_amdgcn_exp2f(-dl);
    }
#pragma unroll
    for (int r = 0; r < 16; ++r) { p0[r] = __builtin_amdgcn_exp2f(p0[r]); p1[r] = __builtin_amdgcn_exp2f(p1[r]); }
    float ps = 0;
#pragma unroll
    for (int r = 0; r < 16; ++r) ps += p0[r];
#pragma unroll
    for (int r = 0; r < 16; ++r) ps += p1[r];
    { auto rr = __builtin_amdgcn_permlane32_swap(__float_as_uint(ps), __float_as_uint(ps), false, false);
      ps = __uint_as_float(rr[0]) + __uint_as_float(rr[1]); }
    l_reg = l_reg * alpha + ps;
    PK4(p0, 0, pa0); PK4(p0, 8, pa1); PK4(p1, 0, pa2); PK4(p1, 8, pa3);
}
template <int KB, bool ROPE, int NREG = 8, bool CINIT = false>
__device__ __forceinline__ void qkt(f32x16& p0, f32x16& p1, const char* lds, int r32, int hi, const bf16x8* qr, const char* qpark = nullptr, const f32x16* cinit = nullptr) {
    if constexpr (!CINIT) { p0 = f32x16{}; p1 = f32x16{}; }
    int ysw = (hi * 16) ^ ((r32 & 15) << 4); asm volatile("" : "+v"(ysw));
    const char* krow = lds + kn_off(KB) + r32 * 256;
#pragma unroll
    for (int d0 = 0; d0 < 8; ++d0) { const char* a = krow + ((d0 * 32) ^ ysw);
        bf16x8 b0 = *reinterpret_cast<const bf16x8*>(a);
        bf16x8 b1 = *reinterpret_cast<const bf16x8*>(a + 32 * 256);
        bf16x8 qf; if (d0 < NREG) qf = qr[d0]; else qf = *reinterpret_cast<const bf16x8*>(qpark + (d0 - NREG) * 1024);
        if (CINIT && d0 == 0) { p0 = __builtin_amdgcn_mfma_f32_32x32x16_bf16(b0, qf, *cinit, 0, 0, 0); p1 = __builtin_amdgcn_mfma_f32_32x32x16_bf16(b1, qf, *cinit, 0, 0, 0); }
        else { p0 = __builtin_amdgcn_mfma_f32_32x32x16_bf16(b0, qf, p0, 0, 0, 0);
               p1 = __builtin_amdgcn_mfma_f32_32x32x16_bf16(b1, qf, p1, 0, 0, 0); } }
    if constexpr (ROPE) {
#pragma unroll
        for (int d0 = 0; d0 < 4; ++d0) { const char* a = lds + OFF_KR + KB * SHM_KR + KRSWZ(r32, (d0 * 16 + hi * 8) * 2);
            bf16x8 b0 = *reinterpret_cast<const bf16x8*>(a);
            bf16x8 b1 = *reinterpret_cast<const bf16x8*>(a + 32 * 128);
            bf16x8 qf; if (NREG >= 12) qf = qr[8 + d0]; else qf = *reinterpret_cast<const bf16x8*>(qpark + d0 * 1024);
            p0 = __builtin_amdgcn_mfma_f32_32x32x16_bf16(b0, qf, p0, 0, 0, 0);
            p1 = __builtin_amdgcn_mfma_f32_32x32x16_bf16(b1, qf, p1, 0, 0, 0); }
    }
}
template <int VB>
__device__ __forceinline__ void pv_tile(f32x16* o, int vb0, bf16x8 pa0, bf16x8 pa1, bf16x8 pa2, bf16x8 pa3) {
    const int vbx = VB == 2 ? vb0 + v_off(2) : vb0;
#define TRRD(dst, off) asm volatile("ds_read_b64_tr_b16 %0, %1 offset:%2" : "=&v"(dst) : "v"(vbx), "i"(off) : "memory")
#define PV_D0(d0) do { s16x4 l0, l1, l2, l3, h0, h1, h2, h3; constexpr int b_ = (VB == 2 ? 0 : v_off(VB)) + v_rd_off(d0, 0, 0); \
        TRRD(l0, b_); TRRD(h0, b_ + 2048); TRRD(l1, b_ + 4096); TRRD(h1, b_ + 6144); TRRD(l2, b_ + 8192); TRRD(h2, b_ + 10240); TRRD(l3, b_ + 12288); TRRD(h3, b_ + 14336); \
        asm volatile("s_waitcnt lgkmcnt(0)" ::: "memory"); SBAR();   \
        o[d0] = __builtin_amdgcn_mfma_f32_32x32x16_bf16(pa0, (bf16x8){l0[0], l0[1], l0[2], l0[3], h0[0], h0[1], h0[2], h0[3]}, o[d0], 0, 0, 0);   \
        o[d0] = __builtin_amdgcn_mfma_f32_32x32x16_bf16(pa1, (bf16x8){l1[0], l1[1], l1[2], l1[3], h1[0], h1[1], h1[2], h1[3]}, o[d0], 0, 0, 0);   \
        o[d0] = __builtin_amdgcn_mfma_f32_32x32x16_bf16(pa2, (bf16x8){l2[0], l2[1], l2[2], l2[3], h2[0], h2[1], h2[2], h2[3]}, o[d0], 0, 0, 0);   \
        o[d0] = __builtin_amdgcn_mfma_f32_32x32x16_bf16(pa3, (bf16x8){l3[0], l3[1], l3[2], l3[3], h3[0], h3[1], h3[2], h3[3]}, o[d0], 0, 0, 0); } while (0)
    PV_D0(0); PV_D0(1); PV_D0(2); PV_D0(3);
#undef PV_D0
#undef TRRD
}
#define VMW() asm volatile("s_waitcnt vmcnt(0)" ::: "memory")
__device__ __forceinline__ float silu_f(float z) { return z * __builtin_amdgcn_rcpf(1.0f + __builtin_amdgcn_exp2f(-LOG2E * z)); }
template <int CTRL> __device__ __forceinline__ float dpp_f(float v) { return __builtin_bit_cast(float, __builtin_amdgcn_update_dpp(0, __builtin_bit_cast(int, v), CTRL, 0xf, 0xf, true)); }
template <bool ALLOK>
__device__ __forceinline__ void store_o_t(const f32x16* o, const float* sc, bf16_t* Aw, const u32x4* zz, float* ssq, int qlo, int r32, int hi, char* stg) {
    const int lane = hi * 32 + r32, rr = lane >> 4, ch = lane & 15; const bool odd = (r32 & 1) != 0;
    float ss[16];
    char* sw = stg + ((odd ? 32 + r32 - 1 : r32) * 2);
#pragma unroll
    for (int r = 0; r < 16; ++r) { const int orow = crow(r, hi); float v[4]; ss[r] = 0.f;
#pragma unroll
        for (int d0 = 0; d0 < 4; ++d0) { v[d0] = o[d0][r] * sc[r]; ss[r] += v[d0] * v[d0]; }
#pragma unroll
        for (int dp = 0; dp < 4; dp += 2) { const float x0 = dpp_f<0xB1>(v[dp]), x1 = dpp_f<0xB1>(v[dp + 1]);
            *(unsigned*)(sw + orow * 256 + dp * 64) = odd ? cvtpk(x1, v[dp + 1]) : cvtpk(v[dp], x0); } }
#pragma unroll
    for (int r = 0; r < 16; ++r) ss[r] += dpp_f<0x128>(ss[r]);
#pragma unroll
    for (int r = 0; r < 16; ++r) ss[r] += dpp_f<0x124>(ss[r]);
#pragma unroll
    for (int r = 0; r < 16; ++r) ss[r] += dpp_f<0x122>(ss[r]);
#pragma unroll
    for (int r = 0; r < 16; ++r) ss[r] += dpp_f<0x121>(ss[r]);
    float sx[16];
#pragma unroll
    for (int r = 0; r < 16; ++r) sx[r] = __builtin_bit_cast(float, __builtin_amdgcn_ds_swizzle(__builtin_bit_cast(int, ss[r]), 0x401F));
    asm volatile("s_waitcnt lgkmcnt(0)" ::: "memory");
    if (r32 == 0) {
#pragma unroll
        for (int r = 0; r < 16; ++r) { const int orow = crow(r, hi); if (ALLOK || qlo + orow >= 0) ssq[(long)orow * 32] = ss[r] + sx[r]; } }
#pragma unroll
    for (int i = 0; i < 8; ++i) { const int row = 4 * i + rr; const u32x4 y = *(const u32x4*)(stg + row * 256 + ch * 16); const u32x4 z = zz[i]; u32x4 w;
#pragma unroll
        for (int e = 0; e < 4; ++e) { const float y0 = __builtin_bit_cast(float, y[e] << 16), y1 = __builtin_bit_cast(float, y[e] & 0xffff0000u);
            const float z0 = __builtin_bit_cast(float, z[e] << 16), z1 = __builtin_bit_cast(float, z[e] & 0xffff0000u); w[e] = cvtpk(y0 * silu_f(z0), y1 * silu_f(z1)); }
        if (ALLOK || qlo + row >= 0) *(u32x4*)(Aw + (long)row * LDO + ch * 8) = w; }
}
__device__ __forceinline__ void load_z(u32x4* zz, const bf16_t* Zw, int qlo, int lane) {
    const int rr = lane >> 4, ch = lane & 15;
#pragma unroll
    for (int i = 0; i < 8; ++i) zz[i] = (qlo + 4 * i + rr >= 0) ? *(const u32x4*)(Zw + (long)(4 * i + rr) * LDO + ch * 8) : (u32x4){0u, 0u, 0u, 0u};
}
__device__ __forceinline__ void store_o(const f32x16* o, const float* sc, bf16_t* Aw  , const u32x4* zz, float* ssq  , int qlo, int r32, int hi, char* stg) {
    if (qlo >= 0) store_o_t<true>(o, sc, Aw, zz, ssq, qlo, r32, hi, stg); else store_o_t<false>(o, sc, Aw, zz, ssq, qlo, r32, hi, stg);
}

__device__ __forceinline__ void mla_block(const bf16_t* Qh, const bf16_t* KNh, const bf16_t* KRh, const bf16_t* Vh, bf16_t* Oh, const bf16_t* Zh, float* ssq, int qb, char* lds) {
    int tid_ = threadIdx.x; asm volatile("" : "+v"(tid_));
    const int tid = tid_, wid = __builtin_amdgcn_readfirstlane(tid >> 6), lane = tid & 63, r32 = lane & 31, hi = lane >> 5;
    const int P0 = 256 * qb - 240, NT = 4 * qb + 1;
    const int qlo = P0 + wid * QBLK, qm = qlo + r32 - 4 * hi;
    float* ws = (float*)(lds + OFF_WS) + wid * 64; float* li_l = ws; float* al_l = ws + 32;
    float m_ref = 0.f, l_reg = 0; f32x16 o[4] = {}; f32x16 negm = {};
    const int vb0 = (int)(uintptr_t)lds + v_rd_base(lane);
    int gk0, gk1, gv0, gv1, gkr;
    { const int o0 = 1024 * (2 * wid) + 16 * lane, o1 = o0 + 1024;
      { const int row = o0 >> 8, cb = (o0 & 255) ^ ((row & 15) << 4); gk0 = row * LDK + (cb >> 1); }
      { const int row = o1 >> 8, cb = (o1 & 255) ^ ((row & 15) << 4); gk1 = row * LDK + (cb >> 1); }
      { const int sub = o0 >> 9, w_ = o0 & 511, kk = (sub >> 2) * 8 + (w_ >> 6), c = (sub & 3) * 32 + ((w_ & 63) >> 1), k = (kk & ~0xC) | ((kk & 4) << 1) | ((kk & 8) >> 1); gv0 = k * LDV + c; }
      { const int sub = o1 >> 9, w_ = o1 & 511, kk = (sub >> 2) * 8 + (w_ >> 6), c = (sub & 3) * 32 + ((w_ & 63) >> 1), k = (kk & ~0xC) | ((kk & 4) << 1) | ((kk & 8) >> 1); gv1 = k * LDV + c; }
      { const int o2 = 1024 * wid + 16 * lane, row = o2 >> 7, cb = (o2 & 127) ^ (((row >> 1) & 7) << 4); gkr = row * LDKR + (cb >> 1); } }
    ATT_LAS char* ldsl = (ATT_LAS char*)lds;
#define DMA16(gp, lo) __builtin_amdgcn_global_load_lds((const unsigned*)(gp), (ATT_LAS unsigned*)(ldsl + (lo)), 16, 0, 0)
#define SDMA(t, bf) do { const long k0_ = (long)(t) * KVBLK; \
        DMA16(Vh + k0_ * LDV + gv0, OFF_V + (bf) * SHM_V + 2048 * wid); DMA16(Vh + k0_ * LDV + gv1, OFF_V + (bf) * SHM_V + 2048 * wid + 1024); \
        DMA16(KNh + k0_ * LDK + gk0, OFF_KN + (bf) * SHM_KN + 2048 * wid); DMA16(KNh + k0_ * LDK + gk1, OFF_KN + (bf) * SHM_KN + 2048 * wid + 1024); \
        DMA16(KRh + k0_ * LDKR + gkr, OFF_KR + (bf) * SHM_KR + 1024 * wid); } while (0)
#define RESC(a) do { if (__any((a) < 1.f)) { if (hi == 0) al_l[r32] = (a); asm volatile("s_waitcnt lgkmcnt(0)" ::: "memory");              \
                     for (int d_ = 0; d_ < 4; ++d_) for (int r = 0; r < 16; ++r) o[d_][r] *= al_l[crow(r, hi)]; } } while (0)
#define MASKT(P0_, P1_, t) do { const int kb_ = (t) * KVBLK; if (kb_ + KVBLK - 1 > qlo) mask_tile(P0_, P1_, qm - kb_); } while (0)
    SDMA(0, 0);
    bf16x8 qr[12];
    { int qrow = qlo + r32; qrow = qrow < 0 ? 0 : qrow; const bf16_t* qp = Qh + (long)qrow * LDQM + hi * 8;
#pragma unroll
      for (int d0 = 0; d0 < 12; ++d0) qr[d0] = *(const bf16x8*)(qp + d0 * 16); }
    VMW();
    __syncthreads();
    f32x16 p0, p1; float al; bf16x8 pa0, pa1, pa2, pa3;
#define MLA_STEP(t, BUF) do { const int t_ = (t);                                                         \
        if (t_ + 1 < NT) { SDMA(t_ + 1, (BUF) ^ 1); SBAR(); }                                              \
        if (t_ * KVBLK <= qlo + QBLK - 1) {                                                                \
            qkt<BUF, true, 12, true>(p0, p1, lds, r32, hi, qr, nullptr, &negm);                            \
            MASKT(p0, p1, t_); softmax_c(p0, p1, t_ == 0, m_ref, negm, l_reg, al, pa0, pa1, pa2, pa3); RESC(al); SBAR();   \
            pv_tile<BUF>(o, vb0, pa0, pa1, pa2, pa3); }                                                   \
        VMW();                                                                                             \
        __syncthreads(); } while (0)
    for (int t = 0; t + 1 < NT; t += 2) { MLA_STEP(t, 0); MLA_STEP(t + 1, 1); }
    MLA_STEP(NT - 1, 0);
#undef MLA_STEP
    u32x4 zz[8]; load_z(zz, Zh + (long)qlo * LDO, qlo, lane);
    if (hi == 0) li_l[r32] = l_reg; asm volatile("s_waitcnt lgkmcnt(0)" ::: "memory");
    float rli[16];
#pragma unroll
    for (int r = 0; r < 16; ++r) rli[r] = __builtin_amdgcn_rcpf(li_l[crow(r, hi)]);
    store_o(o, rli, Oh + (long)qlo * LDO, zz, ssq + (long)qlo * 32, qlo, r32, hi, lds + wid * 8192);
    __syncthreads();
#undef MASKT
#undef RESC
#undef SDMA
#undef DMA16
}

__device__ __forceinline__ void sb_elem(f32x16& p0, f32x16& p1, float& carry, bool need_mask, int dq, bool hi0, bf16x8& pa0, bf16x8& pa1, bf16x8& pa2, bf16x8& pa3) {
    f32x16 m0, m1;
    { const f32x16 y0 = p0, y1 = p1; f32x16 e0, e1;
#pragma unroll
      for (int r = 0; r < 16; ++r) { e0[r] = __builtin_amdgcn_exp2f(__builtin_amdgcn_fmed3f(y0[r], 126.f, -__builtin_inff())); e1[r] = __builtin_amdgcn_exp2f(__builtin_amdgcn_fmed3f(y1[r], 126.f, -__builtin_inff())); }
      const f32x16 t0 = e0 + 1.0f, t1 = e1 + 1.0f;
#pragma unroll
      for (int r = 0; r < 16; ++r) { p0[r] = __builtin_amdgcn_rcpf(t0[r]); p1[r] = __builtin_amdgcn_rcpf(t1[r]); }
      m0 = e0 * p0; m1 = e1 * p1; }
    if (need_mask) {
#pragma unroll
        for (int r = 0; r < 16; ++r) { const int c = (r & 3) + 8 * (r >> 2);
            if ((unsigned)(dq - c) >= WBIG) { p0[r] = 0.f; m0[r] = 1.f; }
            if ((unsigned)(dq - c - 32) >= WBIG) { p1[r] = 0.f; m1[r] = 1.f; } }
    }
    float T[8], GH[8];
#pragma unroll
    for (int m = 0; m < 8; ++m) { const float g = m < 4 ? (m0[4 * m] * m0[4 * m + 1]) * (m0[4 * m + 2] * m0[4 * m + 3]) : (m1[4 * (m - 4)] * m1[4 * (m - 4) + 1]) * (m1[4 * (m - 4) + 2] * m1[4 * (m - 4) + 3]);
        auto rr = __builtin_amdgcn_permlane32_swap(__float_as_uint(g), __float_as_uint(g), false, false);
        T[m] = __uint_as_float(rr[0]) * __uint_as_float(rr[1]); GH[m] = __uint_as_float(rr[1]); }
    float SS = carry;
#pragma unroll
    for (int m = 7; m >= 0; --m) {
        const float t3 = SS * (hi0 ? GH[m] : 1.0f);
        if (m < 4) { const float t2 = t3 * m0[4 * m + 3], t1 = t2 * m0[4 * m + 2], t0 = t1 * m0[4 * m + 1];
            p0[4 * m + 3] *= t3; p0[4 * m + 2] *= t2; p0[4 * m + 1] *= t1; p0[4 * m] *= t0; }
        else { const int q = 4 * (m - 4); const float t2 = t3 * m1[q + 3], t1 = t2 * m1[q + 2], t0 = t1 * m1[q + 1];
            p1[q + 3] *= t3; p1[q + 2] *= t2; p1[q + 1] *= t1; p1[q] *= t0; }
        SS *= T[m];
    }
    carry = SS;
    PK4(p0, 0, pa0); PK4(p0, 8, pa1); PK4(p1, 0, pa2); PK4(p1, 8, pa3);
}
constexpr int OFF_SBFLAG = 131072 + 8192;
struct SbHalf { const bf16_t* Qh; const bf16_t* Kh; const bf16_t* Vh; const bf16_t* Zh; bf16_t* Oh; float* ssq; int hb; };
__device__ __forceinline__ void sb_block2(const SbHalf& HA, const SbHalf& HB, char* lds) {
    int tid_ = threadIdx.x; asm volatile("" : "+v"(tid_));
    const int tid = tid_, wid = __builtin_amdgcn_readfirstlane(tid >> 6), lane = tid & 63, r32 = lane & 31, hi = lane >> 5;
    const int g = wid >> 2, w4 = wid & 3;
    const bf16_t* Qh = g ? HB.Qh : HA.Qh; const bf16_t* Kh = g ? HB.Kh : HA.Kh; const bf16_t* Vh = g ? HB.Vh : HA.Vh; const bf16_t* Zh = g ? HB.Zh : HA.Zh;
    bf16_t* Oh = g ? HB.Oh : HA.Oh; float* ssq = g ? HB.ssq : HA.ssq; const int hb = g ? HB.hb : HA.hb;
    const int NT = 2 * hb + 1, smax = 2 * (HA.hb > HB.hb ? HA.hb : HB.hb) + 1;
    const int qlo = 128 * hb - 112 + w4 * QBLK, qm = qlo + r32 - 4 * hi - 1;
    char* lg = lds + g * 65536;
    f32x16 o[4] = {}; float carry = 1.f; const bool hi0 = hi == 0;
    const int vb0 = (int)(uintptr_t)lg + v_rd_base(lane);
    int gk[4], gv[4];
#pragma unroll
    for (int i = 0; i < 4; ++i) { const int o_ = 1024 * (4 * w4 + i) + 16 * lane;
      { const int row = o_ >> 8, cb = (o_ & 255) ^ ((row & 15) << 4); gk[i] = row * LDK + (cb >> 1); }
      { const int sub = o_ >> 9, w_ = o_ & 511, kk = (sub >> 2) * 8 + (w_ >> 6), c = (sub & 3) * 32 + ((w_ & 63) >> 1), k = (kk & ~0xC) | ((kk & 4) << 1) | ((kk & 8) >> 1); gv[i] = k * LDV + c; } }
    ATT_LAS char* ldsl = (ATT_LAS char*)lg;
#define DMA16(gp, lo) __builtin_amdgcn_global_load_lds((const unsigned*)(gp), (ATT_LAS unsigned*)(ldsl + (lo)), 16, 0, 0)
#define SDMA(t, bf) do { const long k0_ = (long)(t) * KVBLK; _Pragma("unroll") for (int i_ = 0; i_ < 4; ++i_) { \
        DMA16(Vh + k0_ * LDV + gv[i_], OFF_V + (bf) * SHM_V + 4096 * w4 + 1024 * i_); DMA16(Kh + k0_ * LDK + gk[i_], OFF_KN + (bf) * SHM_KN + 4096 * w4 + 1024 * i_); } } while (0)
    SDMA(NT - 1, 0);
    bf16x8 qr[8];
    { int qrow = qlo + r32; qrow = qrow < 0 ? 0 : qrow; const bf16_t* qp = Qh + (long)qrow * LDQS + hi * 8;
#pragma unroll
      for (int d0 = 0; d0 < 8; ++d0) qr[d0] = *(const bf16x8*)(qp + d0 * 16); }
    VMW();
    __syncthreads();
    f32x16 p0, p1; bf16x8 pa0, pa1, pa2, pa3;
    int* flags = (int*)(lds + OFF_SBFLAG); bool wdone = false, stop = false; const bool rowneg = qlo + r32 < 0;
#define SB_STEP(s, BUF) do { const int t_ = NT - 1 - (s); const int kb_ = t_ * KVBLK;     \
        if (t_ > 0) { SDMA(t_ - 1, (BUF) ^ 1); SBAR(); }                                                    \
        if (!wdone && t_ >= 0 && kb_ <= qlo + 30) {                                                         \
            qkt<BUF, false, 8>(p0, p1, lg, r32, hi, qr);                                                  \
            sb_elem(p0, p1, carry, kb_ + KVBLK - 1 >= qlo, qm - kb_, hi0, pa0, pa1, pa2, pa3); SBAR();    \
            pv_tile<BUF>(o, vb0, pa0, pa1, pa2, pa3);                                                     \
            wdone = __all(carry == 0.f || rowneg); }                                                      \
        if (lane == 0) flags[(BUF) * 8 + wid] = (wdone || t_ <= 0) ? 1 : 0;                                 \
        VMW();                                                                                              \
        __syncthreads();                                                                                    \
        { const int* f_ = flags + (BUF) * 8; const int a_ = f_[0] & f_[1] & f_[2] & f_[3] & f_[4] & f_[5] & f_[6] & f_[7];   \
          stop = __builtin_amdgcn_readfirstlane(a_) != 0; } } while (0)
    for (int s_ = 0; s_ < smax && !stop; s_ += 2) { SB_STEP(s_, 0); if (!stop && s_ + 1 < smax) SB_STEP(s_ + 1, 1); }
    u32x4 zz[8]; load_z(zz, Zh + (long)qlo * LDO, qlo, lane);
    float one[16];
#pragma unroll
    for (int r = 0; r < 16; ++r) one[r] = 1.f;
    store_o(o, one, Oh + (long)qlo * LDO, zz, ssq + (long)qlo * 32, qlo, r32, hi, lds + wid * 8192);
    __syncthreads();
#undef SB_STEP
#undef SDMA
#undef DMA16
}
#undef VMW
#undef PK4
#undef SBAR
#undef KSWZ
#undef KRSWZ
#undef ATT_LAS
}

constexpr int NWAVES = 8;
#ifndef MK_MULTI
#define MK_MULTI 0
#endif
constexpr int BATCH = 4, SEQ = 4096, DM = 4096, DEPTH = 4, NMETA = 16, SEQL = SEQ + NMETA;
constexpr int M = BATCH * SEQL;
constexpr int MP = 16640;
constexpr int QL = 1024, KVL = 512, NIN = 12032  , DIN = 11840, NUQ = 3072, NUKV = 4096;
constexpr float EPS = 1e-6f;
constexpr size_t MiB = 1u << 20;
constexpr size_t al2(size_t x) { return (x + 2 * MiB - 1) / (2 * MiB) * (2 * MiB); }
constexpr size_t WS_CTL = 0, CTL_ZERO_BYTES = 1 * MiB;
constexpr size_t WS_ROPE = 2 * MiB;
constexpr size_t WS_WIN = 4 * MiB;
constexpr size_t WS_WUQ = WS_WIN + al2((size_t)DEPTH * NIN * DM * 2);
constexpr size_t WS_WUKV = WS_WUQ + al2((size_t)DEPTH * NUQ * QL * 2);
constexpr size_t WS_WO = WS_WUKV + al2((size_t)DEPTH * NUKV * KVL * 2);
constexpr size_t WS_SSQ = WS_WO + al2((size_t)DEPTH * DM * DM * 2);
constexpr size_t WS_RSTD = WS_SSQ + al2((size_t)MP * 64 * 4);
constexpr size_t WS_U = WS_RSTD + al2((size_t)MP * 4);
constexpr size_t WS_SSQQ = WS_U + al2((size_t)MP * DM * 2);
constexpr size_t WS_SSQKV = WS_SSQQ + al2((size_t)MP * 16 * 4);
constexpr size_t WS_CQN = WS_SSQKV + al2((size_t)MP * 8 * 4);
constexpr size_t WS_CKVN = WS_CQN + al2((size_t)MP * QL * 2);
constexpr size_t WS_KR = WS_CKVN + al2((size_t)MP * KVL * 2);
constexpr size_t WS_Z = WS_KR + al2((size_t)MP * 64 * 2);
constexpr size_t WS_QSB = WS_Z + al2((size_t)MP * 4096 * 2);
constexpr size_t WS_KSB = WS_QSB + al2((size_t)MP * 2048 * 2);
constexpr size_t WS_VSB = WS_KSB + al2((size_t)MP * 2048 * 2);
constexpr size_t WS_QM = WS_VSB + al2((size_t)MP * 2048 * 2);
constexpr size_t WS_KM = WS_QM + al2((size_t)MP * 3072 * 2);
constexpr size_t WS_VM = WS_KM + al2((size_t)MP * 2048 * 2);
constexpr size_t WS_Y = WS_VM + al2((size_t)MP * 2048 * 2);
constexpr size_t WS_A = WS_Y + al2((size_t)MP * 4096 * 2);
constexpr size_t WS_SLAB = WS_A + al2((size_t)MP * 4096 * 2);
constexpr size_t WS_SSQY = WS_SLAB + al2((size_t)16 * 64 * 4096 * 4);
constexpr size_t WS_RATIO = WS_SSQY + al2((size_t)MP * 32 * 4);
constexpr size_t WS_RSB = WS_RATIO + al2((size_t)MP * 4);
constexpr size_t WS_END = WS_RSB + al2((size_t)MP * 4);
constexpr int MFULL = 16384;
constexpr int CW_BAR = 4096;
constexpr int RING_OFF = 0, RING_BYTES = 131072;
constexpr int LDSCTL_OFF = RING_BYTES, MISC_OFF = LDSCTL_OFF + 320;
constexpr int LDS_BYTES = 147456;
static_assert(att::ATT_LDS <= RING_BYTES && att::OFF_SBFLAG + 256 <= LDS_BYTES && att::OFF_SBFLAG >= LDSCTL_OFF + 4096, "attention LDS");

#define GAS __attribute__((address_space(1)))
#define LAS __attribute__((address_space(3)))
typedef unsigned short bf16;
typedef unsigned v4u __attribute__((ext_vector_type(4)));
typedef unsigned v2u __attribute__((ext_vector_type(2)));
typedef float f32x4 __attribute__((ext_vector_type(4)));
typedef GAS unsigned gu32;
#define RLX_AGENT __ATOMIC_RELAXED, __HIP_MEMORY_SCOPE_AGENT
#define LDS_WAIT() asm volatile("s_waitcnt lgkmcnt(0)" ::: "memory")
__device__ __forceinline__ unsigned f2bf(float f) { unsigned u = __builtin_bit_cast(unsigned, f); return (u + 0x7fffu + ((u >> 16) & 1u)) >> 16; }
__device__ __forceinline__ unsigned pk2(float lo, float hi) { return f2bf(lo) | (f2bf(hi) << 16); }
__device__ __forceinline__ float bflo(unsigned w) { return __builtin_bit_cast(float, w << 16); }
__device__ __forceinline__ float bfhi(unsigned w) { return __builtin_bit_cast(float, w & 0xffff0000u); }
#define XB_TMO      128
#define XB_XCNT(j)  (256  + 64 * (j))
#define XB_XSUB(j)  (1280 + 64 * (j))
#define XB_XGEN(j)  (2304 + 64 * (j))
#define XB_TOP      3328
#define XB_TOPGEN   3392
#define XCD_BAR_WORDS 3456
#define XB_SPIN_CAP (1u << 18)

__device__ __forceinline__ unsigned xb_ld(unsigned* p)              { return __hip_atomic_load(p, __ATOMIC_RELAXED, __HIP_MEMORY_SCOPE_AGENT); }
__device__ __forceinline__ unsigned xb_add(unsigned* p, unsigned v) { return __hip_atomic_fetch_add(p, v, __ATOMIC_RELAXED, __HIP_MEMORY_SCOPE_AGENT); }
__device__ __forceinline__ unsigned xb_xcc_id() { return (unsigned)__builtin_amdgcn_s_getreg((3 << 11) | 20) & 0xFu; }
#define XB_SPIN(cond, bar) do { unsigned _sp = 0; while (cond) { __builtin_amdgcn_s_sleep(1); \
    if ((++_sp & 255u) == 0u) { if (xb_ld(&(bar)[XB_TMO])) break; if (_sp > XB_SPIN_CAP) { atomicAdd(&(bar)[XB_TMO], 1u); break; } } } } while (0)

struct XcdBarrier {
    unsigned* bar; unsigned x;
    volatile LAS unsigned* st;
};

__device__ __forceinline__ XcdBarrier xcd_barrier_post(unsigned* bar, volatile LAS unsigned* st) {
    XcdBarrier b; b.bar = bar; b.x = xb_xcc_id(); b.st = st;
    if (threadIdx.x == 0) (void)xb_add(&bar[XB_XCNT(b.x)], 1u);
    return b;
}
__device__ __forceinline__ void xcd_barrier_complete(unsigned* bar, unsigned x, unsigned& nloc, unsigned& nx) {
    const unsigned G = gridDim.x * gridDim.y * gridDim.z;
    unsigned sum, cnt, mine, sp = 0u;
    for (;;) {
        sum = 0u; cnt = 0u; mine = 0u;
#pragma unroll
        for (unsigned j = 0; j < 16; ++j) { const unsigned c = xb_ld(&bar[XB_XCNT(j)]); sum += c; cnt += (c > 0u) ? 1u : 0u; mine = (j == x) ? c : mine; }
        if (sum == G) break;
        __builtin_amdgcn_s_sleep(1);
        if ((++sp & 255u) == 0u) { if (xb_ld(&bar[XB_TMO])) break; if (sp > XB_SPIN_CAP) { atomicAdd(&bar[XB_TMO], 1u); break; } }
    }
    nloc = mine > 0u ? mine : 1u; nx = cnt > 0u ? cnt : 1u;
}

__device__ __forceinline__ void xcd_barrier(const XcdBarrier& b) {
    asm volatile("s_waitcnt vmcnt(0)" ::: "memory");
    __syncthreads();
    if (threadIdx.x == 0) {
        unsigned* bar = b.bar;
        __builtin_amdgcn_s_waitcnt(0);
        unsigned nloc = b.st[0], nx = b.st[1];
        if (nloc == 0u) { xcd_barrier_complete(bar, b.x, nloc, nx); b.st[0] = nloc; b.st[1] = nx; }
        const unsigned old = xb_add(&bar[XB_XSUB(b.x)], 1u);
        const unsigned gen = old / nloc;
        if (old + 1u == (gen + 1u) * nloc) {
            __builtin_amdgcn_fence(__ATOMIC_RELEASE, "agent");
            asm volatile("s_waitcnt vmcnt(0)" ::: "memory");
            const unsigned og = xb_add(&bar[XB_TOP], 1u);
            const unsigned tg = og / nx;
            if (og + 1u == (tg + 1u) * nx) xb_add(&bar[XB_TOPGEN], 1u);
            else XB_SPIN(xb_ld(&bar[XB_TOPGEN]) == tg, bar);
            __builtin_amdgcn_fence(__ATOMIC_ACQUIRE, "agent");
            xb_add(&bar[XB_XGEN(b.x)], 1u);
            asm volatile("s_waitcnt vmcnt(0)" ::: "memory");
        } else {
            XB_SPIN(xb_ld(&bar[XB_XGEN(b.x)]) == gen, bar);
            __builtin_amdgcn_fence(__ATOMIC_ACQUIRE, "agent");
            asm volatile("s_waitcnt vmcnt(0)" ::: "memory");
        }
    }
    __syncthreads();
}

struct Frame {
    LAS unsigned char* lds;
    volatile LAS unsigned* MISC;
    gu32* ctl;
    int tid, lane, wave, vcu, G;
};
__device__ __forceinline__ float wave_sum(float v) {
#pragma unroll
    for (int o = 1; o < 64; o <<= 1) v += __shfl_xor(v, o);
    return v;
}
__device__ __forceinline__ void transpose_item(const float* W, int N, int K, bf16* WT, int src_col0, int dst_row0, int k0, LAS float* scr, int lane, const float* gk) {
    float tv[32];
#pragma unroll
    for (int i = 0; i < 32; ++i) { const int kk = 2 * i + (lane >> 5); tv[i] = W[(size_t)(k0 + kk) * N + src_col0 + (lane & 31)]; }
#pragma unroll
    for (int i = 0; i < 32; ++i) { const int kk = 2 * i + (lane >> 5); scr[kk * 33 + (lane & 31)] = gk ? tv[i] * gk[k0 + kk] : tv[i]; }
    LDS_WAIT(); asm volatile("" ::: "memory");
    const int c = lane & 7;
#pragma unroll
    for (int j = 0; j < 4; ++j) { const int n = (lane >> 3) + 8 * j; const LAS float* s = scr + (8 * c) * 33 + n;
        v4u o; o.x = pk2(s[0 * 33], s[1 * 33]); o.y = pk2(s[2 * 33], s[3 * 33]); o.z = pk2(s[4 * 33], s[5 * 33]); o.w = pk2(s[6 * 33], s[7 * 33]);
        *(GAS v4u*)(WT + (size_t)(dst_row0 + n) * K + k0 + 8 * c) = o; }
    LDS_WAIT(); asm volatile("" ::: "memory");
}
template <int MODE>
__device__ __forceinline__ void h_row(const float* src, bf16* HB, int row, bool tail, const float* slab, float* RSTD, const float* g, float* out, int lane) {
    f32x4 v[8][2];
    if (MODE == 0) { const GAS f32x4* sr = (const GAS f32x4*)src + 2 * lane;
#pragma unroll
        for (int j = 0; j < 8; ++j) { v[j][0] = sr[128 * j]; v[j][1] = sr[128 * j + 1]; } }
    else { const GAS v4u* hr = (const GAS v4u*)(HB + (size_t)row * DM) + lane;
#pragma unroll
        for (int j = 0; j < 8; ++j) { const v4u h = hr[64 * j]; v[j][0] = (f32x4){bflo(h.x), bfhi(h.x), bflo(h.y), bfhi(h.y)}; v[j][1] = (f32x4){bflo(h.z), bfhi(h.z), bflo(h.w), bfhi(h.w)}; }
        if (tail) for (int s = 0; s < 16; ++s) { const GAS f32x4* pr = (const GAS f32x4*)(slab + ((size_t)s * 64 + (row - MFULL)) * DM) + 2 * lane;
#pragma unroll
            for (int j = 0; j < 8; ++j) { v[j][0] += pr[128 * j]; v[j][1] += pr[128 * j + 1]; } } }
    float ss = 0.f;
    if (MODE != 2) {
        GAS v4u* hw = (GAS v4u*)(HB + (size_t)row * DM) + lane;
#pragma unroll
        for (int j = 0; j < 8; ++j) { v4u w; w.x = pk2(v[j][0].x, v[j][0].y); w.y = pk2(v[j][0].z, v[j][0].w); w.z = pk2(v[j][1].x, v[j][1].y); w.w = pk2(v[j][1].z, v[j][1].w);
            if (MODE == 0 || tail) hw[64 * j] = w;
#pragma unroll
            for (int e = 0; e < 4; ++e) { const float a = bflo(w[e]), b = bfhi(w[e]); ss += a * a + b * b; } }
        const float rstd = 1.0f / sqrtf(wave_sum(ss) * (1.0f / DM) + EPS);
        if (lane == 0) RSTD[row] = rstd;
    } else {
#pragma unroll
        for (int j = 0; j < 8; ++j) ss += (v[j][0].x * v[j][0].x + v[j][0].y * v[j][0].y) + (v[j][0].z * v[j][0].z + v[j][0].w * v[j][0].w) + (v[j][1].x * v[j][1].x + v[j][1].y * v[j][1].y) + (v[j][1].z * v[j][1].z + v[j][1].w * v[j][1].w);
        const float rstd = 1.0f / sqrtf(wave_sum(ss) * (1.0f / DM) + EPS);
        const int b = row / SEQL, t = row % SEQL;
        GAS f32x4* orow = (GAS f32x4*)(out + ((size_t)b * SEQ + (t - NMETA)) * DM) + 2 * lane; const GAS f32x4* gr = (const GAS f32x4*)g + 2 * lane;
#pragma unroll
        for (int j = 0; j < 8; ++j) { orow[128 * j] = (v[j][0] * rstd) * gr[128 * j]; orow[128 * j + 1] = (v[j][1] * rstd) * gr[128 * j + 1]; }
    }
}
template <int MODE>
__device__ __forceinline__ void h_rows(Frame& F, const float* x, const float* meta, bf16* HB, const float* slab, const float* SSQ, float* RSTD, const float* g, float* out) {
    const int gw = F.vcu * NWAVES + F.wave, NGW = F.G * NWAVES; int lane = F.lane; asm volatile("" : "+v"(lane));
    if (MODE == 0) {
        for (int row = gw; row < MP; row += NGW) {
            if (row >= M) { GAS v4u* hw = (GAS v4u*)(HB + (size_t)row * DM) + lane;
#pragma unroll
                for (int j = 0; j < 8; ++j) hw[64 * j] = (v4u){0u, 0u, 0u, 0u};
                if (lane == 0) RSTD[row] = 0.f;
                continue; }
            const int b = row / SEQL, t = row % SEQL;
            h_row<0>(t < NMETA ? meta + (size_t)t * DM : x + ((size_t)b * SEQ + (t - NMETA)) * DM, HB, row, false, nullptr, RSTD, nullptr, nullptr, lane);
        }
    } else {
        for (int i4 = F.vcu; i4 < (M - MFULL) * 4; i4 += F.G) if ((i4 & 3) == 0) {
            const int row = MFULL + (i4 >> 2), col = 512 * F.wave + 8 * lane;
            const v4u hv = *(const GAS v4u*)(HB + (size_t)row * DM + col);
            f32x4 a0 = (f32x4){bflo(hv.x), bfhi(hv.x), bflo(hv.y), bfhi(hv.y)}, a1 = (f32x4){bflo(hv.z), bfhi(hv.z), bflo(hv.w), bfhi(hv.w)};
            f32x4 s0[16], s1[16];
#pragma unroll
            for (int s = 0; s < 16; ++s) { const GAS f32x4* pr = (const GAS f32x4*)(slab + ((size_t)s * 64 + (row - MFULL)) * DM + col); s0[s] = pr[0]; s1[s] = pr[1]; }
#pragma unroll
            for (int s = 0; s < 16; ++s) { a0 += s0[s]; a1 += s1[s]; }
            float ss;
            if (MODE == 1) { v4u w; w.x = pk2(a0.x, a0.y); w.y = pk2(a0.z, a0.w); w.z = pk2(a1.x, a1.y); w.w = pk2(a1.z, a1.w);
                *(GAS v4u*)(HB + (size_t)row * DM + col) = w; ss = 0.f;
#pragma unroll
                for (int e = 0; e < 4; ++e) { const float p = bflo(w[e]), q = bfhi(w[e]); ss += p * p + q * q; } }
            else ss = (a0.x * a0.x + a0.y * a0.y) + (a0.z * a0.z + a0.w * a0.w) + (a1.x * a1.x + a1.y * a1.y) + (a1.z * a1.z + a1.w * a1.w);
            ss = wave_sum(ss);
            LAS float* red = (LAS float*)(F.lds + RING_OFF);
            if (lane == 0) red[F.wave] = ss;
            __syncthreads();
            float tot = 0.f;
#pragma unroll
            for (int w = 0; w < NWAVES; ++w) tot += red[w];
            const float rstd = 1.0f / sqrtf(tot * (1.0f / DM) + EPS);
            if (MODE == 1) { if (F.wave == 0 && lane == 0) RSTD[row] = rstd; }
            else { const int b = row / SEQL, t = row % SEQL; GAS f32x4* orow = (GAS f32x4*)(out + ((size_t)b * SEQ + (t - NMETA)) * DM + col); const GAS f32x4* gr = (const GAS f32x4*)(g + col);
                orow[0] = (a0 * rstd) * gr[0]; orow[1] = (a1 * rstd) * gr[1]; }
            __syncthreads();
        }
        if (MODE == 1) {
            for (int r4 = gw * 4; r4 < MFULL; r4 += NGW * 4) { const int row = r4 + (lane >> 4);
                const f32x4 v = *(const GAS f32x4*)(SSQ + (size_t)row * 64 + (lane & 15) * 4); float s = (v.x + v.y) + (v.z + v.w);
                s += __shfl_xor(s, 1); s += __shfl_xor(s, 2); s += __shfl_xor(s, 4); s += __shfl_xor(s, 8);
                if ((lane & 15) == 0) RSTD[row] = 1.0f / sqrtf(s * (1.0f / DM) + EPS); }
        } else {
            for (int row = gw; row < MFULL; row += NGW) { if (row % SEQL < NMETA) continue; h_row<2>(nullptr, HB, row, false, slab, RSTD, g, out, lane); }
        }
    }
}
__device__ __forceinline__ void p0_prologue(Frame& F, const float* const* in, unsigned char* ws) {
    LAS float* scr = (LAS float*)(F.lds + RING_OFF + F.wave * 16384);
    const int gw = F.vcu * NWAVES + F.wave, NGW = F.G * NWAVES;
    const float *w_in = in[3], *w_uq = in[6], *w_ukv = in[7], *w_o = in[10];
    bf16* Win_t = (bf16*)(ws + WS_WIN); bf16* Wuq_t = (bf16*)(ws + WS_WUQ); bf16* Wukv_t = (bf16*)(ws + WS_WUKV); bf16* Wo_t = (bf16*)(ws + WS_WO);
    constexpr int C_IN = 64 * 370, C_UQ = 16 * 96, C_UKV = 8 * 128, C_WO = 64 * 128, C_L = C_IN + C_UQ + C_UKV + C_WO;
    for (int it = gw; it < DEPTH * C_L; it += NGW) {
        const int l = it / C_L; int r = it % C_L;
        if (r < C_IN) { const int kb = r / 370, sb = r % 370, src = 32 * sb; const int dst = src < 1536 ? src : (src == 1536 ? 1536 : (src == 1568 ? 1664 : src + 192));
            transpose_item(w_in + (size_t)l * DM * DIN, DIN, DM, Win_t + (size_t)l * NIN * DM, src, dst, 64 * kb, scr, F.lane, in[2] + (size_t)l * DM); continue; }
        r -= C_IN;
        if (r < C_UQ) { const int kb = r / 96, sb = r % 96, hd = sb / 6, jb = sb % 6; const int dst = jb < 4 ? hd * 128 + jb * 32 : (8 + hd / 4) * 256 + (jb - 4) * 128 + (hd % 4) * 32;
            transpose_item(w_uq + (size_t)l * QL * NUQ, NUQ, QL, Wuq_t + (size_t)l * NUQ * QL, 32 * sb, dst, 64 * kb, scr, F.lane, in[4] + (size_t)l * QL); continue; }
        r -= C_UQ;
        if (r < C_UKV) { const int kb = r / 128, sb = r % 128, hd = sb / 8, jb = sb % 8; const int dst = jb < 4 ? hd * 128 + jb * 32 : 2048 + hd * 128 + (jb - 4) * 32;
            transpose_item(w_ukv + (size_t)l * KVL * NUKV, NUKV, KVL, Wukv_t + (size_t)l * NUKV * KVL, 32 * sb, dst, 64 * kb, scr, F.lane, in[5] + (size_t)l * KVL); continue; }
        r -= C_UKV;
        { const int kb = r / 128, sb = r % 128; transpose_item(w_o + (size_t)l * DM * DM, DM, DM, Wo_t + (size_t)l * DM * DM, 32 * sb, 32 * sb, 64 * kb, scr, F.lane, kb < 32 ? in[8] + (size_t)l * 2048 : in[9] + (size_t)l * 2048 - 2048); }
    }
    const int gtid = F.vcu * (NWAVES * 64) + F.tid, NT = F.G * NWAVES * 64;
    for (int idx = gtid; idx < DEPTH * 192 * 512; idx += NT) {
        const int l = idx / (192 * 512), r = idx % (192 * 512), row = r / 512, c16 = r % 512, drow = row < 96 ? 1568 + row : 1696 + (row - 96);
        *(GAS v4u*)(Win_t + ((size_t)l * NIN + drow) * DM + c16 * 8) = (v4u){0u, 0u, 0u, 0u}; }
    for (int idx = gtid; idx < (MP - M) * 512; idx += NT) *(GAS v4u*)((bf16*)(ws + WS_A) + (size_t)M * 4096 + (size_t)idx * 8) = (v4u){0u, 0u, 0u, 0u};
    float* rope = (float*)(ws + WS_ROPE);
    for (int idx = gtid; idx < SEQL * 32; idx += NT) { const int pos = idx >> 5, i = idx & 31;
        const float inv = powf(10000.0f, -(float)(2 * i) / 64.0f), ang = (float)pos * inv;
        rope[pos * 64 + i] = cosf(ang); rope[pos * 64 + 32 + i] = sinf(ang); }
    h_rows<0>(F, in[0], in[1], (bf16*)(ws + WS_U), nullptr, nullptr, (float*)(ws + WS_RSTD), nullptr, nullptr);
}

struct Args { const float* in[12]; float* out; unsigned char* ws; int ph_lo, ph_hi; };
constexpr int NPH = 1 + 7 * DEPTH;
__global__ void __launch_bounds__(NWAVES * 64, 2) hymba_fwd(Args args) {
    extern __shared__ __attribute__((aligned(16))) unsigned char lds[];
    Frame F;
    F.lds = (LAS unsigned char*)lds;
    F.MISC = (volatile LAS unsigned*)(F.lds + MISC_OFF);
    F.tid = threadIdx.x; F.lane = F.tid & 63; F.wave = __builtin_amdgcn_readfirstlane(F.tid >> 6);
    F.G = gridDim.x; { const int bx = blockIdx.x; F.vcu = (F.G % 8 == 0) ? (bx % 8) * (F.G / 8) + bx / 8 : bx; }
    unsigned char* ws = args.ws;
    F.ctl = (gu32*)(ws + WS_CTL);
    for (int u = F.tid; u < (LDS_BYTES - LDSCTL_OFF) / 4; u += NWAVES * 64) ((LAS unsigned*)(F.lds + LDSCTL_OFF))[u] = 0u;
    __syncthreads();
    XcdBarrier bar; bar.bar = (unsigned*)(F.ctl + CW_BAR); bar.x = 0; bar.st = nullptr;
    if (!MK_MULTI) bar = xcd_barrier_post((unsigned*)(F.ctl + CW_BAR), F.MISC + 8);
    const int lo = args.ph_lo, hi = args.ph_hi;
#ifndef PHMASK
#define PHMASK 0x1ff
#endif
#define EN(t) (((PHMASK) >> (t)) & 1)
#define IN(k) (lo <= (k) && (k) < hi)
#ifndef REP_BAR
#define REP_BAR 1
#endif
#define GRID_BAR(k) do { if (IN((k) + 1)) { if (!MK_MULTI) for (int rb_ = 0; rb_ < REP_BAR; ++rb_) xcd_barrier(bar); } } while (0)
#define WSL_() GAS unsigned char* wsl = (GAS unsigned char*)ws; asm volatile("" : "+s"(wsl))
#define U ((bf16*)(wsl + WS_U))
#define SSQ ((float*)(wsl + WS_SSQ))
#define RSTD ((float*)(wsl + WS_RSTD))
#define SSQY ((float*)(wsl + WS_SSQY))
#define RATIO ((float*)(wsl + WS_RATIO))
#define RSB ((float*)(wsl + WS_RSB))
#define SSQQ ((float*)(wsl + WS_SSQQ))
#define SSQKV ((float*)(wsl + WS_SSQKV))
#define CQN ((bf16*)(wsl + WS_CQN))
#define CKVN ((bf16*)(wsl + WS_CKVN))
#define KR ((bf16*)(wsl + WS_KR))
#define Zb ((bf16*)(wsl + WS_Z))
#define QSB ((bf16*)(wsl + WS_QSB))
#define KSB ((bf16*)(wsl + WS_KSB))
#define VSB ((bf16*)(wsl + WS_VSB))
#define QM ((bf16*)(wsl + WS_QM))
#define KM ((bf16*)(wsl + WS_KM))
#define VM ((bf16*)(wsl + WS_VM))
#define A ((bf16*)(wsl + WS_A))
#define rope ((const float*)(wsl + WS_ROPE))

    #ifndef REP_THIN
#define REP_THIN 1
#endif
    if (EN(0) && IN(0)) { for (int rep = 0; rep < REP_THIN; ++rep) p0_prologue(F, args.in, ws); GRID_BAR(0); }
    for (int l = 0; l < DEPTH; ++l) {
        const int pb = 1 + 7 * l;
        if (EN(1) && IN(pb)) {
            WSL_();
            pg8::Gemm g{U, (const bf16*)(wsl + WS_WIN) + (size_t)l * NIN * DM, MP, NIN, DM}; pg8::InAOrder S{F.G, (int)blockIdx.x};
            pg8::EpiIn E{CQN, CKVN, SSQQ, SSQKV, KR, Zb, QSB, KSB, VSB, rope, RSTD};
            pg8::gemm_phase<pg8::EpiIn, pg8::InAOrder, true, true>(F.lds + RING_OFF, g, S, E);
            GRID_BAR(pb);
        }
        if (EN(3) && IN(pb + 2)) {
            WSL_();
            { pg8::Gemm g{U, (const bf16*)(wsl + WS_WIN) + (size_t)l * NIN * DM, MP, NIN, DM}; pg8::InBOrder S{F.G, (int)blockIdx.x};
              pg8::EpiIn E{CQN, CKVN, SSQQ, SSQKV, KR, Zb, QSB, KSB, VSB, rope, RSTD};
              pg8::gemm_phase<pg8::EpiIn, pg8::InBOrder, true, true>(F.lds + RING_OFF, g, S, E); }
            { pg8::Gemm g{CQN, (const bf16*)(wsl + WS_WUQ) + (size_t)l * NUQ * QL, MP, NUQ, QL}; pg8::StaticOrder S; S.init(MP, NUQ, F.G, (int)(F.G - 1 - blockIdx.x));
              pg8::EpiUq E{QM, rope, SSQQ};
              pg8::gemm_phase<pg8::EpiUq, pg8::StaticOrder, true, true>(F.lds + RING_OFF, g, S, E); }
            { pg8::Gemm g{CKVN, (const bf16*)(wsl + WS_WUKV) + (size_t)l * NUKV * KVL, MP, NUKV, KVL};
              pg8::DynOrder S{(GAS unsigned*)(wsl + WS_CTL) + 64 + 16 * l, (volatile LAS unsigned*)(F.lds + LDSCTL_OFF + 4096), MP / 256, NUKV / 256, (MP / 256) * (NUKV / 256), 2, F.G, (int)blockIdx.x};
              pg8::EpiUkv E{KM, VM, SSQKV};
              pg8::gemm_phase<pg8::EpiUkv, pg8::DynOrder, true, true>(F.lds + RING_OFF, g, S, E); }
            GRID_BAR(pb + 2);
        }
        if (IN(pb + 3)) {
            WSL_(); char* al = (char*)lds + RING_OFF;
            const int npair = (512 - F.vcu + F.G - 1) / F.G;
            const int m0a = F.vcu, m0b = (F.vcu + F.G - 64 % F.G) % F.G;
            const int nmeta_a = m0a < 64 ? (63 - m0a) / F.G + 1 : 0, nmeta_b = m0b < 64 ? (63 - m0b) / F.G + 1 : 0;
#ifndef REP_MLA
#define REP_MLA 1
#endif
            if (EN(4)) for (int rep = 0; rep < REP_MLA; ++rep) {
#pragma clang loop unroll(disable)
                for (int j = 0; j < 2 * npair + nmeta_a; ++j) {
                    int bh, qb;
                    if (j < 2 * npair) { const int item = F.vcu + F.G * (j >> 1), p = item & 7; bh = item >> 3; qb = (j & 1) ? 1 + p : 16 - p; }
                    else { bh = m0a + F.G * (j - 2 * npair); qb = 0; }
                    const size_t row0 = (size_t)(bh >> 4) * SEQL; const int hd = bh & 15;
                    att::mla_block(QM + row0 * 3072 + hd * 192, KM + row0 * 2048 + hd * 128, KR + row0 * 64, VM + row0 * 2048 + hd * 128, A + row0 * 4096 + hd * 128, Zb + row0 * 4096 + hd * 128, SSQY + row0 * 32 + hd, qb, al);
                }
            }
#ifndef REP_SB
#define REP_SB 1
#endif
            if (EN(5)) {
                const int dyn0 = 2 * F.G < 1024 ? 2 * F.G : 1024; int js = 0, nextdyn = 0;
                volatile LAS unsigned* slot = (volatile LAS unsigned*)(F.lds + LDSCTL_OFF + 4096 + 64);
                GAS unsigned* sbctr = (GAS unsigned*)(wsl + WS_CTL) + 2048 + 32 * l;
                int t0_ = threadIdx.x; asm volatile("" : "+v"(t0_)); const int w0_ = __builtin_amdgcn_readfirstlane(t0_ >> 6);
                if (!(F.vcu < dyn0)) {
                    if (t0_ == 0) slot[0] = __hip_atomic_fetch_add(sbctr, 1u, __ATOMIC_RELAXED, __HIP_MEMORY_SCOPE_AGENT);
                    __syncthreads(); nextdyn = __builtin_amdgcn_readfirstlane((int)slot[0]); }
#pragma clang loop unroll(disable)
                for (;;) {
                    int item;
                    if (js < 2 && F.vcu + F.G * js < dyn0) { item = F.vcu + F.G * js; ++js; }
                    else { js = 2; item = dyn0 + nextdyn; if (item >= 1024 + 32) break; }
                    const bool ndyn = !(js < 2 && F.vcu + F.G * js < dyn0);
                    unsigned pend_ = 0;
                    if (ndyn && w0_ == 0) asm volatile("s_mov_b64 exec, 1\n\tglobal_atomic_add %0, %1, %2, off sc0\n\ts_mov_b64 exec, -1" : "=v"(pend_) : "v"(sbctr), "v"(1u) : "memory");
                    const bool meta = item >= 1024; if (meta) item -= 1024;
                    const int ppq = 15 - (item >> 6);
                    const int bhA = meta ? 2 * item : item & 63, bhB = meta ? 2 * item + 1 : bhA, hbA = meta ? 0 : 2 * ppq + 1, hbB = meta ? 0 : hbA + 1;
                    const size_t rA = (size_t)(bhA >> 4) * SEQL, rB = (size_t)(bhB >> 4) * SEQL; const int hA = bhA & 15, hB = bhB & 15;
                    const att::SbHalf HA{QSB + rA * 2048 + hA * 128, KSB + rA * 2048 + hA * 128, VSB + rA * 2048 + hA * 128, Zb + rA * 4096 + 2048 + hA * 128, A + rA * 4096 + 2048 + hA * 128, SSQY + rA * 32 + 16 + hA, hbA};
                    const att::SbHalf HB{QSB + rB * 2048 + hB * 128, KSB + rB * 2048 + hB * 128, VSB + rB * 2048 + hB * 128, Zb + rB * 4096 + 2048 + hB * 128, A + rB * 4096 + 2048 + hB * 128, SSQY + rB * 32 + 16 + hB, hbB};
                    att::sb_block2(HA, HB, al);
                    if (ndyn) { if (w0_ == 0) { asm volatile("s_waitcnt vmcnt(0)" ::: "memory"); if (t0_ == 0) slot[0] = pend_; }
                        __syncthreads(); nextdyn = __builtin_amdgcn_readfirstlane((int)slot[0]); }
                }
            }
            GRID_BAR(pb + 3);
        }
        if (EN(7) && IN(pb + 5)) {
            WSL_();
            LAS float* ytab = (LAS float*)(F.lds + LDSCTL_OFF + 1024);
#define FILL_YTAB(pm_) do { int t0_ = F.tid; asm volatile("" : "+v"(t0_)); for (int r_ = t0_; r_ < 256; r_ += NWAVES * 64) { const int row_ = (pm_) * 256 + r_; float ra_ = 0.f, rb_ = 0.f;                                  \
                if (row_ < M) { const GAS f32x4* sp_ = (const GAS f32x4*)(SSQY + (size_t)row_ * 32); float s1_ = 0.f, s2_ = 0.f;                                                  \
                    _Pragma("unroll") for (int j_ = 0; j_ < 4; ++j_) { const f32x4 a_ = sp_[j_], b_ = sp_[4 + j_]; s1_ += (a_.x + a_.y) + (a_.z + a_.w); s2_ += (b_.x + b_.y) + (b_.z + b_.w); } \
                    const float r1_ = 1.0f / sqrtf(s1_ * (1.0f / 2048) + EPS), r2_ = 1.0f / sqrtf(s2_ * (1.0f / 2048) + EPS); ra_ = r1_ / r2_; rb_ = r2_; }                     \
                ytab[r_] = ra_; ytab[256 + r_] = rb_; } __syncthreads(); } while (0)
            { pg8::Gemm g{A, (const bf16*)(wsl + WS_WO) + (size_t)l * DM * DM, 16384, DM, DM, DM}; pg8::StaticOrder S; S.init(16384, DM, F.G, (int)blockIdx.x);
              { pg8::Unit u0; if (S.next(0, u0)) FILL_YTAB(u0.pm); else __syncthreads(); }
              pg8::EpiResBf E{U, SSQ, (const LAS float*)ytab};
              pg8::gemm_phase<pg8::EpiResBf, pg8::StaticOrder, true, true>(F.lds + RING_OFF, g, S, E); }
#if defined(REP_OUT)
#endif
            { pg8::Gemm g{A, (const bf16*)(wsl + WS_WO) + (size_t)l * DM * DM, MP, DM, 256, DM}; pg8::SplitKOrder S{64, 16, 16, 256, F.G, (int)blockIdx.x};
              FILL_YTAB(64);
              pg8::EpiSlab E{(float*)(wsl + WS_SLAB), 256, (const LAS float*)ytab};
              pg8::gemm_phase<pg8::EpiSlab, pg8::SplitKOrder, true, true>(F.lds + RING_OFF, g, S, E); }
#undef FILL_YTAB
            GRID_BAR(pb + 5);
        }
        if (EN(8) && IN(pb + 6)) {
            WSL_();
            if (l + 1 < DEPTH) { h_rows<1>(F, nullptr, nullptr, U, (const float*)(wsl + WS_SLAB), SSQ, RSTD, nullptr, nullptr); GRID_BAR(pb + 6); }
            else h_rows<2>(F, nullptr, nullptr, U, (const float*)(wsl + WS_SLAB), SSQ, RSTD, args.in[11], args.out);
        }
    }
#undef IN
#undef GRID_BAR
#undef WSL_
#undef U
#undef SSQ
#undef RSTD
#undef SSQY
#undef RATIO
#undef RSB
#undef SSQQ
#undef SSQKV
#undef CQN
#undef CKVN
#undef KR
#undef Zb
#undef QSB
#undef KSB
#undef VSB
#undef QM
#undef KM
#undef VM
#undef A
#undef rope
}

extern "C" void kernel_launch(void* const* d_in, const int* in_sizes, int n_in, void* d_out, int out_size, void* d_ws, size_t ws_size, hipStream_t stream) {
    static int grid = 0;
    if (grid == 0) {
        if (n_in != 12 || in_sizes[0] != BATCH * SEQ * DM || out_size != BATCH * SEQ * DM || ws_size < WS_END) {
            fprintf(stderr, "kernel_launch: shape/workspace mismatch (n_in %d, in0 %d, out %d, ws %zu, need %zu); nothing launched\n", n_in, n_in > 0 ? in_sizes[0] : -1, out_size, ws_size, (size_t)WS_END); grid = -1; return; }
        int dev = 0, cus = 0, per_cu = 0;
        if (hipGetDevice(&dev) != hipSuccess || hipDeviceGetAttribute(&cus, hipDeviceAttributeMultiprocessorCount, dev) != hipSuccess) { grid = -1; return; }
        if (hipFuncSetAttribute((const void*)hymba_fwd, hipFuncAttributeMaxDynamicSharedMemorySize, LDS_BYTES) != hipSuccess) { fprintf(stderr, "kernel_launch: hipFuncSetAttribute failed\n"); grid = -1; return; }
        if (hipOccupancyMaxActiveBlocksPerMultiprocessor(&per_cu, (const void*)hymba_fwd, NWAVES * 64, LDS_BYTES) != hipSuccess || per_cu < 1)
            fprintf(stderr, "kernel_launch: note: occupancy query reports %d workgroups per CU\n", per_cu);
        (void)hipGetLastError();
        grid = cus;
    }
    if (grid < 0) return;
    if (hipMemsetAsync((char*)d_ws + WS_CTL, 0, CTL_ZERO_BYTES, stream) != hipSuccess) return;
    Args a{};
    for (int i = 0; i < 12; ++i) a.in[i] = (const float*)d_in[i];
    a.out = (float*)d_out; a.ws = (unsigned char*)d_ws;
#if MK_MULTI
    for (int ph = 0; ph < NPH; ++ph) { a.ph_lo = ph; a.ph_hi = ph + 1; hipLaunchKernelGGL(hymba_fwd, dim3(grid), dim3(NWAVES * 64), LDS_BYTES, stream, a); }
#else
    a.ph_lo = 0; a.ph_hi = NPH;
    hipLaunchKernelGGL(hymba_fwd, dim3(grid), dim3(NWAVES * 64), LDS_BYTES, stream, a);
#endif
    const hipError_t le = hipPeekAtLastError();
    if (le != hipSuccess) fprintf(stderr, "kernel_launch: launch failed: %s\n", hipGetErrorName(le));
}
```

```cpp
#include <hip/hip_runtime.h>
#include <hip/hip_bf16.h>
#include <cstdio>
#include <cstdint>
#include <cmath>
namespace pg8 {
#define PG8_LAS __attribute__((address_space(3)))
typedef unsigned short bf16_t;
typedef short bf16x8 __attribute__((ext_vector_type(8)));
typedef float f32x4 __attribute__((ext_vector_type(4)));
typedef unsigned u32x4 __attribute__((ext_vector_type(4)));
constexpr int BM = 256, BK = 64, HALF = 128, HTB = HALF * BK * 2  , STAGE_BYTES = 8 * HTB, NXCD = 8, WGM = 8;

__host__ __device__ __forceinline__ int lds_byte(int r, int c) { const int st = (r >> 4) * 2 + (c >> 5), rr = r & 15, cc = c & 31, ob = rr * 64 + cc * 2; return st * 1024 + (ob ^ (((ob >> 9) & 1) << 5)); }
__host__ __device__ __forceinline__ void stage_rc(int b, int& R, int& C) { const int st = b / 1024, sb = b % 1024, swz = sb ^ (((sb >> 9) & 1) << 5); R = (st >> 1) * 16 + swz / 64; C = (st & 1) * 32 + (swz % 64) / 2; }
__host__ __device__ __forceinline__ int perm32(int rho) { const int n = rho >> 4, i = rho & 15; return 8 * (i >> 2) + 4 * n + (i & 3); }

struct Unit { int pm, pn, koff; };
struct Gemm { const bf16_t* A; const bf16_t* Bt; int M, N, K, ld; };

struct StaticOrder {
    int nM, nN, nwg, G, c;
    __host__ __device__ void init(int M, int N, int G_, int c_) { nM = M / BM; nN = N / BM; nwg = nM * nN; G = G_; c = c_; }
    __host__ __device__ __forceinline__ bool next(int i, Unit& u) const {
        const long L = (long)i * G + c; if (L >= nwg) return false;
        int wgid = (int)L; { const int q = nwg / NXCD, r = nwg % NXCD, xcd = wgid % NXCD, off = wgid / NXCD; wgid = (xcd < r ? xcd * (q + 1) : r * (q + 1) + (xcd - r) * q) + off; }
        const int nig = WGM * nN, gid = wgid / nig, fm = gid * WGM, gsz = (nM - fm) < WGM ? (nM - fm) : WGM;
        u.pm = fm + ((wgid % nig) % gsz); u.pn = (wgid % nig) / gsz; u.koff = 0; return true;
    }
    __device__ __forceinline__ void a_ready(const Unit&) const {}
    __device__ __forceinline__ void done(const Unit&) const {}
};
struct InAOrder {
    int G, c;
    __host__ __device__ __forceinline__ bool next(int i, Unit& u) const {
        const int L = i * G + c; if (L >= 512) return false;
        const int x = L & 7, j = L >> 3;
        if (x < 7) { u.pm = 8 * x + (j & 7); u.pn = j >> 3; }
        else if (j < 54) { u.pm = 56 + j % 9; u.pn = j / 9; }
        else { const int jj = j - 54; u.pm = 56 + jj % 5; u.pn = 6 + jj / 5; }
        u.koff = 0; return true;
    }
    __device__ __forceinline__ void a_ready(const Unit&) const {}
    __device__ __forceinline__ void done(const Unit&) const {}
};
struct InBOrder {
    int G, c;
    __host__ __device__ __forceinline__ bool next(int i, Unit& u) const {
        constexpr int nM = 65, nN = 39, nwg = nM * nN;
        const int L = i * G + c; if (L >= nwg + 8) return false;
        u.koff = 0;
        if (L >= nwg) { const int k = L - nwg; u.pm = 61 + (k & 3); u.pn = 6 + (k >> 2); return true; }
        int wgid = L; { constexpr int q = nwg / NXCD, r = nwg % NXCD; const int xcd = wgid % NXCD, off = wgid / NXCD; wgid = (xcd < r ? xcd * (q + 1) : r * (q + 1) + (xcd - r) * q) + off; }
        constexpr int nig = WGM * nN; const int gid = wgid / nig, fm = gid * WGM, gsz = (nM - fm) < WGM ? (nM - fm) : WGM;
        u.pm = fm + ((wgid % nig) % gsz); u.pn = 8 + (wgid % nig) / gsz; return true;
    }
    __device__ __forceinline__ void a_ready(const Unit&) const {}
    __device__ __forceinline__ void done(const Unit&) const {}
};
struct DynOrder {
    __attribute__((address_space(1))) unsigned* ctr; volatile PG8_LAS unsigned* slot; int nM, nN, nwg, nstat, G, c;
    __device__ __forceinline__ bool next(int i, Unit& u) const {
        int L;
        if (i < nstat) L = i * G + c;
        else {
            int t_ = threadIdx.x; asm volatile("" : "+v"(t_));
            if (t_ == 0) { const unsigned v = __hip_atomic_fetch_add(ctr, 1u, __ATOMIC_RELAXED, __HIP_MEMORY_SCOPE_AGENT); slot[i & 1] = (unsigned)(nstat * G) + v; }
            asm volatile("s_waitcnt lgkmcnt(0)" ::: "memory"); __builtin_amdgcn_s_barrier(); asm volatile("" ::: "memory");
            L = __builtin_amdgcn_readfirstlane((int)slot[i & 1]);
        }
        if (L >= nwg) return false;
        const int nig = WGM * nN, gid = L / nig, fm = gid * WGM, gsz = (nM - fm) < WGM ? (nM - fm) : WGM;
        u.pm = fm + ((L % nig) % gsz); u.pn = (L % nig) / gsz; u.koff = 0; return true;
    }
    __device__ __forceinline__ void a_ready(const Unit&) const {}
    __device__ __forceinline__ void done(const Unit&) const {}
};
struct SplitKOrder {
    int pm, nN, nS, kslice, G, c;
    __host__ __device__ __forceinline__ bool next(int i, Unit& u) const { const int L = i * G + c; if (L >= nN * nS) return false; u.pm = pm; u.pn = L % nN; u.koff = (L / nN) * kslice; return true; }
    __device__ __forceinline__ void a_ready(const Unit&) const {}
    __device__ __forceinline__ void done(const Unit&) const {}
};

__device__ __forceinline__ unsigned cvt_pk_bf16(float lo, float hi) { unsigned r; asm volatile("v_cvt_pk_bf16_f32 %0, %1, %2" : "=v"(r) : "v"(lo), "v"(hi)); return r; }
typedef float f32x2 __attribute__((ext_vector_type(2)));

constexpr int SEQL = 4112;
__device__ __forceinline__ void st8_bf16(bf16_t* p, f32x4 v0, f32x4 v1) {
    u32x4 w; w.x = cvt_pk_bf16(v0[0], v0[1]); w.y = cvt_pk_bf16(v0[2], v0[3]); w.z = cvt_pk_bf16(v1[0], v1[1]); w.w = cvt_pk_bf16(v1[2], v1[3]);
    *(u32x4*)p = w;
}
__device__ __forceinline__ float bf_lo(unsigned w) { return __builtin_bit_cast(float, w << 16); }
__device__ __forceinline__ float bf_hi(unsigned w) { return __builtin_bit_cast(float, w & 0xffff0000u); }
__device__ __forceinline__ float st8_bf16_ss(bf16_t* p, f32x4 v0, f32x4 v1) {
    u32x4 w; w.x = cvt_pk_bf16(v0[0], v0[1]); w.y = cvt_pk_bf16(v0[2], v0[3]); w.z = cvt_pk_bf16(v1[0], v1[1]); w.w = cvt_pk_bf16(v1[2], v1[3]);
    *(u32x4*)p = w; float ss = 0.f;
#pragma unroll
    for (int e = 0; e < 4; ++e) { const float x = bf_lo(w[e]), y = bf_hi(w[e]); ss += x * x + y * y; }
    return ss;
}
__device__ __forceinline__ void rope8(const float* tab, f32x4 x1a, f32x4 x1b, f32x4 x2a, f32x4 x2b, bf16_t* o1, bf16_t* o2) {
    const f32x4 c0 = *(const f32x4*)tab, c1 = *(const f32x4*)(tab + 4), s0 = *(const f32x4*)(tab + 32), s1 = *(const f32x4*)(tab + 36);
    st8_bf16(o1, x1a * c0 - x2a * s0, x1b * c1 - x2b * s1);
    st8_bf16(o2, x2a * c0 + x1a * s0, x2b * c1 + x1b * s1);
}
struct EpiIn {
    static constexpr bool PERM = true, AFTER_DRAIN = false, MID = false, PRE = true;
    bf16_t* CQN; bf16_t* CKVN; float* SSQQ; float* SSQKV; bf16_t* KR; bf16_t* Z; bf16_t* QSB; bf16_t* KSB; bf16_t* VSB; const float* rope; const float* rstd;
    __device__ __forceinline__ void pre(float (&p)[4], const Unit& u, int wr, int wc, int fr, int fq) const {
        const int row = u.pm * BM + wr * 64 + fr + (fq >> 1) * HALF + (fq & 1) * 32;
        p[0] = rstd[row]; p[1] = rstd[row + 16];
    }
    __device__ __forceinline__ void epi(const f32x4 (&acc)[2][2][4][2], const Unit& u, int wr, int wc, int fr, int fq, const float (&p)[4]) const {
        const int pn = u.pn, row0 = u.pm * BM + wr * 64 + fr, cin = wc * 32 + 8 * fq;
        float rs[2][4];
#pragma unroll
        for (int ai = 0; ai < 2; ++ai)
#pragma unroll
            for (int m = 0; m < 4; ++m) rs[ai][m] = __shfl(p[m & 1], fr + 16 * (2 * ai + (m >> 1)));
        if (pn < 6) {
            bf16_t* base; float* sq; int ldc, col, nsl, sl;
            if (pn < 4) { base = CQN; ldc = 1024; col = pn * 256; sq = SSQQ; nsl = 16; sl = 4 * pn + wc; } else { base = CKVN; ldc = 512; col = (pn - 4) * 256; sq = SSQKV; nsl = 8; sl = 4 * (pn - 4) + wc; }
#pragma unroll
            for (int ai = 0; ai < 2; ++ai)
#pragma unroll
                for (int m = 0; m < 4; ++m) { const int row = row0 + ai * HALF + m * 16; bf16_t* rowp = base + (size_t)row * ldc + col + cin; float ss = 0.f;
#pragma unroll
                    for (int bj = 0; bj < 2; ++bj) ss += st8_bf16_ss(rowp + bj * HALF, acc[ai][bj][m][0] * rs[ai][m], acc[ai][bj][m][1] * rs[ai][m]);
                    ss += __shfl_xor(ss, 16); ss += __shfl_xor(ss, 32);
                    if (fq == 0) sq[(size_t)row * nsl + sl] = ss; }
        } else if (pn == 6) {
            if (wc == 0) {
#pragma unroll
                for (int ai = 0; ai < 2; ++ai)
#pragma unroll
                    for (int m = 0; m < 4; ++m) { const int row = row0 + ai * HALF + m * 16, pos = row % SEQL;
                        bf16_t* o = KR + (size_t)row * 64 + 8 * fq;
                        rope8(rope + pos * 64 + 8 * fq, acc[ai][0][m][0] * rs[ai][m], acc[ai][0][m][1] * rs[ai][m], acc[ai][1][m][0] * rs[ai][m], acc[ai][1][m][1] * rs[ai][m], o, o + 32); }
            }
        } else {
            bf16_t* base; int ldc, col; float qs = 1.f;
            if (pn < 15) { base = Z; ldc = 4096; col = (pn - 7) * 256; }
            else if (pn < 23) { base = QSB; ldc = 2048; col = (pn - 15) * 256; qs = -0.12751743f; }
            else if (pn < 31) { base = KSB; ldc = 2048; col = (pn - 23) * 256; }
            else if (pn < 39) { base = VSB; ldc = 2048; col = (pn - 31) * 256; }
            else { base = Z; ldc = 4096; col = 2048 + (pn - 39) * 256; }
#pragma unroll
            for (int ai = 0; ai < 2; ++ai)
#pragma unroll
                for (int m = 0; m < 4; ++m) { bf16_t* rowp = base + (size_t)(row0 + ai * HALF + m * 16) * ldc + col + cin;
#pragma unroll
                    for (int bj = 0; bj < 2; ++bj) st8_bf16(rowp + bj * HALF, acc[ai][bj][m][0] * (rs[ai][m] * qs), acc[ai][bj][m][1] * (rs[ai][m] * qs)); }
        }
    }
};
struct EpiUq {
    static constexpr bool PERM = true, AFTER_DRAIN = false, MID = false, PRE = true;
    bf16_t* QM; const float* rope; const float* SSQQ;
    __device__ __forceinline__ void pre(float (&p)[4], const Unit& u, int wr, int wc, int fr, int fq) const {
        const int row = u.pm * BM + wr * 64 + fr + (fq >> 1) * HALF + (fq & 1) * 32;
#pragma unroll
        for (int j = 0; j < 2; ++j) { const f32x4* sp = (const f32x4*)(SSQQ + (size_t)(row + 16 * j) * 16); const f32x4 a = sp[0], b = sp[1], c = sp[2], d = sp[3];
            const float s = ((a[0] + a[1]) + (a[2] + a[3])) + ((b[0] + b[1]) + (b[2] + b[3])) + ((c[0] + c[1]) + (c[2] + c[3])) + ((d[0] + d[1]) + (d[2] + d[3]));
            p[j] = 1.0f / sqrtf(s * (1.0f / 1024.0f) + 1e-6f); }
    }
    __device__ __forceinline__ void epi(const f32x4 (&acc)[2][2][4][2], const Unit& u, int wr, int wc, int fr, int fq, const float (&p)[4]) const {
        const int pn = u.pn, row0 = u.pm * BM + wr * 64 + fr, cin = wc * 32 + 8 * fq;
#define RSQ_(ai, m) (__shfl(p[(m) & 1], fr + 16 * (2 * (ai) + ((m) >> 1))) * 0.10411754f)
        if (pn < 8) {
#pragma unroll
            for (int ai = 0; ai < 2; ++ai)
#pragma unroll
                for (int m = 0; m < 4; ++m) { bf16_t* rowp = QM + (size_t)(row0 + ai * HALF + m * 16) * 3072 + cin; const float r_ = RSQ_(ai, m);
#pragma unroll
                    for (int bj = 0; bj < 2; ++bj) st8_bf16(rowp + (2 * pn + bj) * 192, acc[ai][bj][m][0] * r_, acc[ai][bj][m][1] * r_); }
        } else {
            const int head = 4 * (pn - 8) + wc;
#pragma unroll
            for (int ai = 0; ai < 2; ++ai)
#pragma unroll
                for (int m = 0; m < 4; ++m) { const int row = row0 + ai * HALF + m * 16, pos = row % SEQL; const float r_ = RSQ_(ai, m);
                    bf16_t* o = QM + (size_t)row * 3072 + head * 192 + 128 + 8 * fq;
                    rope8(rope + pos * 64 + 8 * fq, acc[ai][0][m][0] * r_, acc[ai][0][m][1] * r_, acc[ai][1][m][0] * r_, acc[ai][1][m][1] * r_, o, o + 32); }
        }
#undef RSQ_
    }
};
struct EpiUkv {
    static constexpr bool PERM = true, AFTER_DRAIN = false, MID = false, PRE = true;
    bf16_t* KM; bf16_t* VM; const float* SSQKV;
    __device__ __forceinline__ void pre(float (&p)[4], const Unit& u, int wr, int wc, int fr, int fq) const {
        const int row = u.pm * BM + wr * 64 + fr + (fq >> 1) * HALF + (fq & 1) * 32;
#pragma unroll
        for (int j = 0; j < 2; ++j) { const f32x4* sp = (const f32x4*)(SSQKV + (size_t)(row + 16 * j) * 8); const f32x4 a = sp[0], b = sp[1];
            const float s = ((a[0] + a[1]) + (a[2] + a[3])) + ((b[0] + b[1]) + (b[2] + b[3]));
            p[j] = 1.0f / sqrtf(s * (1.0f / 512.0f) + 1e-6f); }
    }
    __device__ __forceinline__ void epi(const f32x4 (&acc)[2][2][4][2], const Unit& u, int wr, int wc, int fr, int fq, const float (&p)[4]) const {
        const int pn = u.pn, row0 = u.pm * BM + wr * 64 + fr, cin = wc * 32 + 8 * fq;

        bf16_t* base = pn < 8 ? KM : VM; const int col = (pn & 7) * 256;
#pragma unroll
        for (int ai = 0; ai < 2; ++ai)
#pragma unroll
            for (int m = 0; m < 4; ++m) { bf16_t* rowp = base + (size_t)(row0 + ai * HALF + m * 16) * 2048 + col + cin;
                const float r_ = __shfl(p[m & 1], fr + 16 * (2 * ai + (m >> 1)));
#pragma unroll
                for (int bj = 0; bj < 2; ++bj) st8_bf16(rowp + bj * HALF, acc[ai][bj][m][0] * r_, acc[ai][bj][m][1] * r_); }
    }
};
struct EpiResBf {
    static constexpr bool PERM = true, AFTER_DRAIN = false, MID = true, PRE = false;
    bf16_t* HB; float* SSQ; const PG8_LAS float* tab;
    __device__ __forceinline__ void mid(f32x4 (&acc)[2][2][4][2], const Unit& u, int wr, int wc, int fr, int fq) const {
        const int row0 = wr * 64 + fr; float f[2][4];
#pragma unroll
        for (int ai = 0; ai < 2; ++ai)
#pragma unroll
            for (int m = 0; m < 4; ++m) f[ai][m] = tab[row0 + ai * HALF + m * 16];
#pragma unroll
        for (int ai = 0; ai < 2; ++ai)
#pragma unroll
            for (int bj = 0; bj < 2; ++bj)
#pragma unroll
                for (int m = 0; m < 4; ++m)
#pragma unroll
                    for (int n = 0; n < 2; ++n) acc[ai][bj][m][n] *= f[ai][m];
    }
    __device__ __forceinline__ void operator()(const f32x4 (&acc)[2][2][4][2], const Unit& u, int wr, int wc, int fr, int fq) const {
        const int row0 = u.pm * BM + wr * 64 + fr, col0 = u.pn * BM + wc * 32 + 8 * fq;
#pragma unroll
        for (int ai = 0; ai < 2; ++ai) {
            u32x4 hv[4][2]; float rsbv[4];
#pragma unroll
            for (int m = 0; m < 4; ++m) { rsbv[m] = tab[256 + wr * 64 + fr + ai * HALF + m * 16];
#pragma unroll
                for (int bj = 0; bj < 2; ++bj) hv[m][bj] = *(const u32x4*)(HB + (size_t)(row0 + ai * HALF + m * 16) * 4096 + col0 + bj * HALF); }
#pragma unroll
            for (int m = 0; m < 4; ++m) { const int row = row0 + ai * HALF + m * 16; float ss = 0.f; const float rsb = rsbv[m];
#pragma unroll
                for (int bj = 0; bj < 2; ++bj) { const u32x4 h = hv[m][bj]; const f32x4 a0 = acc[ai][bj][m][0] * rsb, a1 = acc[ai][bj][m][1] * rsb;
                    u32x4 w; w.x = cvt_pk_bf16(bf_lo(h.x) + a0[0], bf_hi(h.x) + a0[1]); w.y = cvt_pk_bf16(bf_lo(h.y) + a0[2], bf_hi(h.y) + a0[3]);
                    w.z = cvt_pk_bf16(bf_lo(h.z) + a1[0], bf_hi(h.z) + a1[1]); w.w = cvt_pk_bf16(bf_lo(h.w) + a1[2], bf_hi(h.w) + a1[3]);
                    *(u32x4*)(HB + (size_t)row * 4096 + col0 + bj * HALF) = w;
#pragma unroll
                    for (int e = 0; e < 4; ++e) { const float x = bf_lo(w[e]), y = bf_hi(w[e]); ss += x * x + y * y; } }
                ss += __shfl_xor(ss, 16); ss += __shfl_xor(ss, 32);
                if (fq == 0) SSQ[(size_t)row * 64 + 4 * u.pn + wc] = ss; }
            asm volatile("" ::: "memory");
        }
    }
};

struct EpiSlab {
    static constexpr bool PERM = false, AFTER_DRAIN = false, MID = false, PRE = false;
    float* slab; int kslice; const PG8_LAS float* tab;
    __device__ __forceinline__ void operator()(const f32x4 (&acc)[2][2][4][2], const Unit& u, int wr, int wc, int fr, int fq) const {
        if (wr != 0) return;
        float* base = slab + (size_t)(u.koff / kslice) * 64 * 4096 + u.pn * BM + wc * 32 + 4 * fq;
#pragma unroll
        for (int m = 0; m < 4; ++m) { float* rowp = base + (size_t)(fr + m * 16) * 4096; const int row = u.pm * BM + fr + m * 16;
            const float sc = u.koff < 2048 ? tab[fr + m * 16] * tab[256 + fr + m * 16] : tab[256 + fr + m * 16];
#pragma unroll
            for (int bj = 0; bj < 2; ++bj)
#pragma unroll
                for (int n = 0; n < 2; ++n) *(f32x4*)(rowp + bj * HALF + n * 16) = acc[0][bj][m][n] * sc; }
    }
};

template <class Epi, class Sched, bool ALIGN_EPI = false, bool SP2 = false>
__device__ __forceinline__ void gemm_phase(PG8_LAS unsigned char* lds, const Gemm g, const Sched& S, const Epi& E) {
    int tid_ = threadIdx.x; asm volatile("" : "+v"(tid_));
    const int tid = tid_, wid = __builtin_amdgcn_readfirstlane(tid >> 6), lane = tid & 63, wr = wid >> 2, wc = wid & 3, fr = lane & 15, fq = lane >> 4;
    const int K = g.K, nt = K / BK, LD = g.ld ? g.ld : g.K;
    unsigned voffA[2], voffB[2];
#pragma unroll
    for (int i = 0; i < 2; ++i) { int R, C; stage_rc(tid * 16 + i * 8192, R, C); const int Rb = Epi::PERM ? ((R & ~31) + perm32(R & 31)) : R;
        voffA[i] = (unsigned)(R * LD + C) * 2u; voffB[i] = (unsigned)(Rb * LD + C) * 2u; }
    const size_t kstep = (size_t)(BK * 2);
    const size_t hstep = (size_t)HALF * LD * 2;
    const size_t tstep = 2 * hstep;
    const unsigned ldsw = (unsigned)wid * 1024u;
    const int aoff = lds_byte(wr * 64 + fr, fq * 8), boff = lds_byte(wc * 32 + fr, fq * 8);
#define PG8_SA(b, h) (((b) * 2 + (h)) * HTB)
#define PG8_SB(b, h) ((4 + (b) * 2 + (h)) * HTB)
#define PG8_STAGE(bufoff, gbase, voff) do { _Pragma("unroll") for (int _i = 0; _i < 2; ++_i) \
        __builtin_amdgcn_global_load_lds((const unsigned*)((const char*)(gbase) + (voff)[_i]), (PG8_LAS unsigned*)(lds + (bufoff) + ldsw + _i * 8192), 16, 0, 0); } while (0)
#define PG8_LDA(dst, b, h) do { _Pragma("unroll") for (int m = 0; m < 4; ++m) _Pragma("unroll") for (int k = 0; k < 2; ++k) dst[m][k] = *(const PG8_LAS bf16x8*)(lds + PG8_SA(b, h) + aoff + m * 2048 + k * 1024); } while (0)
#define PG8_LDB(dst, b, h) do { _Pragma("unroll") for (int n = 0; n < 2; ++n) _Pragma("unroll") for (int k = 0; k < 2; ++k) dst[n][k] = *(const PG8_LAS bf16x8*)(lds + PG8_SB(b, h) + boff + n * 2048 + k * 1024); } while (0)
#define PG8_MMA(ai, bj, At, Bt) do { __builtin_amdgcn_s_setprio(1); _Pragma("unroll") for (int m = 0; m < 4; ++m) _Pragma("unroll") for (int n = 0; n < 2; ++n) _Pragma("unroll") for (int k = 0; k < 2; ++k) \
        acc[ai][bj][m][n] = __builtin_amdgcn_mfma_f32_16x16x32_bf16(Bt[n][k], At[m][k], acc[ai][bj][m][n], 0, 0, 0); __builtin_amdgcn_s_setprio(0); } while (0)
#define PG8_WAIT_V(n) asm volatile("s_waitcnt vmcnt(" #n ")" ::: "memory")
#define PG8_WAIT_L(n) asm volatile("s_waitcnt lgkmcnt(" #n ")" ::: "memory")
#define PG8_BAR __builtin_amdgcn_s_barrier()
#define PG8_SCHED __builtin_amdgcn_sched_barrier(0)
    Unit cur, nxt; int ui = 0; float epre[4];
    if (!S.next(0, cur)) return;
    f32x4 acc[2][2][4][2];
#pragma unroll
    for (int a = 0; a < 2; ++a)
#pragma unroll
        for (int b = 0; b < 2; ++b)
#pragma unroll
            for (int m = 0; m < 4; ++m)
#pragma unroll
                for (int n = 0; n < 2; ++n) acc[a][b][m][n] = (f32x4){0.f, 0.f, 0.f, 0.f};
    bf16x8 At[4][2], B0[2][2], B1[2][2];
    const char* cA = (const char*)g.A + (size_t)cur.pm * tstep + (size_t)cur.koff * 2; const char* cB = (const char*)g.Bt + (size_t)cur.pn * tstep + (size_t)cur.koff * 2;
    S.a_ready(cur);
    if constexpr (SP2) {
        PG8_STAGE(PG8_SB(0, 0), cB, voffB); PG8_STAGE(PG8_SB(0, 1), cB + hstep, voffB); PG8_STAGE(PG8_SA(0, 0), cA, voffA); PG8_STAGE(PG8_SA(0, 1), cA + hstep, voffA);
        if (wr == 1) PG8_BAR;
        PG8_WAIT_V(2); PG8_BAR;
        PG8_STAGE(PG8_SB(1, 0), cB + kstep, voffB); PG8_STAGE(PG8_SA(1, 0), cA + kstep, voffA); PG8_STAGE(PG8_SB(1, 1), cB + hstep + kstep, voffB);
        PG8_WAIT_V(6); PG8_BAR;
    } else {
        PG8_STAGE(PG8_SB(0, 0), cB, voffB); PG8_STAGE(PG8_SA(0, 0), cA, voffA); PG8_STAGE(PG8_SB(0, 1), cB + hstep, voffB); PG8_STAGE(PG8_SA(0, 1), cA + hstep, voffA);
        if (wr == 1) PG8_BAR;
        PG8_WAIT_V(4); PG8_BAR;
        PG8_STAGE(PG8_SB(1, 0), cB + kstep, voffB); PG8_STAGE(PG8_SA(1, 0), cA + kstep, voffA); PG8_STAGE(PG8_SB(1, 1), cB + hstep + kstep, voffB);
        PG8_WAIT_V(6); PG8_BAR;
    }
    for (;;) {
        const bool has_next = S.next(ui + 1, nxt);
        const char* nA = has_next ? (const char*)g.A + (size_t)nxt.pm * tstep + (size_t)nxt.koff * 2 : cA; const char* nB = has_next ? (const char*)g.Bt + (size_t)nxt.pn * tstep + (size_t)nxt.koff * 2 : cB;
        for (int t = 0; t < nt; t += 2) {
            if constexpr (Epi::PRE) { if (t == (nt >> 1) - 2) E.pre(epre, cur, wr, wc, fr, fq); }
            if constexpr (Epi::MID) { if (t == (nt >> 1)) E.mid(acc, cur, wr, wc, fr, fq); }
            const bool last = (t == nt - 2);
            const char* a1 = cA + (size_t)(t + 1) * kstep;
            const char* a2 = last ? nA : cA + (size_t)(t + 2) * kstep; const char* b2 = last ? nB : cB + (size_t)(t + 2) * kstep;
            const char* a3 = a2 + kstep; const char* b3 = b2 + kstep;
            if (last && has_next) S.a_ready(nxt);
            if constexpr (SP2) {
            PG8_LDB(B0, 0, 0); PG8_LDB(B1, 0, 1); PG8_SCHED; PG8_LDA(At, 0, 0); PG8_STAGE(PG8_SA(1, 1), a1 + hstep, voffA);
            PG8_WAIT_V(8); PG8_WAIT_L(0); PG8_BAR; PG8_MMA(0, 0, At, B0); PG8_MMA(0, 1, At, B1); PG8_BAR; PG8_SCHED;
            PG8_LDA(At, 0, 1); PG8_STAGE(PG8_SB(0, 0), b2, voffB); PG8_STAGE(PG8_SB(0, 1), b2 + hstep, voffB); PG8_STAGE(PG8_SA(0, 0), a2, voffA);
            PG8_WAIT_V(8); PG8_WAIT_L(0); PG8_BAR; PG8_MMA(1, 0, At, B0); PG8_MMA(1, 1, At, B1); PG8_BAR; PG8_SCHED;
            PG8_LDB(B0, 1, 0); PG8_LDB(B1, 1, 1); PG8_SCHED; PG8_LDA(At, 1, 0); PG8_STAGE(PG8_SA(0, 1), a2 + hstep, voffA);
            PG8_WAIT_V(8); PG8_WAIT_L(0); PG8_BAR; PG8_MMA(0, 0, At, B0); PG8_MMA(0, 1, At, B1); PG8_BAR; PG8_SCHED;
            PG8_LDA(At, 1, 1); PG8_STAGE(PG8_SB(1, 0), b3, voffB); PG8_STAGE(PG8_SB(1, 1), b3 + hstep, voffB); PG8_STAGE(PG8_SA(1, 0), a3, voffA);
            PG8_WAIT_V(8); PG8_WAIT_L(0); PG8_BAR; PG8_MMA(1, 0, At, B0); PG8_MMA(1, 1, At, B1); PG8_BAR; PG8_SCHED;
            } else {
            PG8_LDB(B0, 0, 0); PG8_SCHED; PG8_LDA(At, 0, 0); PG8_STAGE(PG8_SA(1, 1), a1 + hstep, voffA);
            PG8_WAIT_L(8); PG8_BAR; PG8_WAIT_L(0); PG8_MMA(0, 0, At, B0); PG8_BAR; PG8_SCHED;
            PG8_LDB(B1, 0, 1); PG8_STAGE(PG8_SB(0, 0), b2, voffB);
            PG8_BAR; PG8_WAIT_L(0); PG8_MMA(0, 1, At, B1); PG8_BAR;
            PG8_LDA(At, 0, 1); PG8_STAGE(PG8_SA(0, 0), a2, voffA);
            PG8_BAR; PG8_WAIT_L(0); PG8_MMA(1, 0, At, B0); PG8_BAR; PG8_SCHED;
            PG8_STAGE(PG8_SB(0, 1), b2 + hstep, voffB);
            PG8_WAIT_V(6); PG8_BAR; PG8_MMA(1, 1, At, B1); PG8_BAR;
            PG8_LDB(B0, 1, 0); PG8_SCHED; PG8_LDA(At, 1, 0); PG8_STAGE(PG8_SA(0, 1), a2 + hstep, voffA);
            PG8_WAIT_L(8); PG8_BAR; PG8_WAIT_L(0); PG8_MMA(0, 0, At, B0); PG8_BAR; PG8_SCHED;
            PG8_LDB(B1, 1, 1); PG8_STAGE(PG8_SB(1, 0), b3, voffB);
            PG8_BAR; PG8_WAIT_L(0); PG8_MMA(0, 1, At, B1); PG8_BAR;
            PG8_LDA(At, 1, 1); PG8_STAGE(PG8_SA(1, 0), a3, voffA);
            PG8_BAR; PG8_WAIT_L(0); PG8_MMA(1, 0, At, B0); PG8_BAR; PG8_SCHED;
            PG8_STAGE(PG8_SB(1, 1), b3 + hstep, voffB);
            PG8_WAIT_V(6); PG8_BAR; PG8_MMA(1, 1, At, B1); PG8_BAR;
            }
        }
        if constexpr (ALIGN_EPI) { if (wr == 0) PG8_BAR; }
        if constexpr (!Epi::AFTER_DRAIN) { if constexpr (Epi::PRE) E.epi(acc, cur, wr, wc, fr, fq, epre); else E(acc, cur, wr, wc, fr, fq); S.done(cur); }
        if (!has_next) break;
#pragma unroll
        for (int a = 0; a < 2; ++a)
#pragma unroll
            for (int b = 0; b < 2; ++b)
#pragma unroll
                for (int m = 0; m < 4; ++m)
#pragma unroll
                    for (int n = 0; n < 2; ++n) acc[a][b][m][n] = (f32x4){0.f, 0.f, 0.f, 0.f};
        cur = nxt; cA = nA; cB = nB; ++ui;
        if constexpr (ALIGN_EPI) { if (wr == 1) PG8_BAR; }
    }
    PG8_WAIT_V(0);
    if constexpr (!ALIGN_EPI) { if (wr == 0) PG8_BAR; }
    PG8_BAR;
    if constexpr (Epi::AFTER_DRAIN) { E.fused(acc, cur, wr, wc, fr, fq, lds, wid, lane); S.done(cur); }
#undef PG8_SA
#undef PG8_SB
#undef PG8_STAGE
#undef PG8_LDA
#undef PG8_LDB
#undef PG8_MMA
#undef PG8_WAIT_V
#undef PG8_WAIT_L
#undef PG8_BAR
#undef PG8_SCHED
}
}

namespace att {
typedef unsigned short bf16_t;
typedef short bf16x8 __attribute__((ext_vector_type(8)));
typedef short s16x4 __attribute__((ext_vector_type(4)));
typedef float f32x16 __attribute__((ext_vector_type(16)));
typedef float f32x4 __attribute__((ext_vector_type(4)));
typedef unsigned u32x4 __attribute__((ext_vector_type(4)));
constexpr int NW = 8, QBLK = 32, KVBLK = 64, QB = NW * QBLK;
constexpr int SHM_V = KVBLK * 128 * 2, SHM_KN = KVBLK * 128 * 2, SHM_KR = KVBLK * 64 * 2;
constexpr int OFF_V = 0, OFF_KN = 2 * SHM_V, OFF_KR = OFF_KN + 2 * SHM_KN, OFF_WS = OFF_KR + 2 * SHM_KR, OFF_QR = OFF_WS + NW * 64 * 4, ATT_LDS = OFF_QR + NW * 4096;
constexpr int kn_off(int b) { return b == 2 ? OFF_QR : OFF_KN + b * SHM_KN; }
constexpr int v_off(int b) { return b == 2 ? OFF_KR : OFF_V + b * SHM_V; }
constexpr int LDQM = 3072, LDK = 2048, LDKR = 64, LDV = 2048, LDO = 4096, LDQS = 2048;
constexpr float LOG2E = 1.4426950408889634f;
constexpr float MLA_SCALE = 0.07216878364870323f;
constexpr float SB_SCALE = 0.08838834764831845f;
constexpr unsigned WBIG = 0x40000000u;

#define KSWZ(row, colB) ((row) * 256 + ((colB) ^ (((row) & 15) << 4)))
#define KRSWZ(row, colB) ((row) * 128 + ((colB) ^ ((((row) >> 1) & 7) << 4)))
#define SBAR() __builtin_amdgcn_sched_barrier(0)
#define ATT_LAS __attribute__((address_space(3)))
__device__ __forceinline__ int v_st(int k, int c) { const int kk = (k & ~0xC) | ((k & 4) << 1) | ((k & 8) >> 1); return ((kk >> 3) * 4 + (c >> 5)) * 512 + ((kk & 7) * 32 + (c & 31)) * 2; }
__device__ __forceinline__ int v_rd_base(int lane) { return ((lane & 3) << 3) | (((lane >> 2) & 3) << 6) | (((lane >> 4) & 1) << 5) | (((lane >> 5) & 1) << 8); }
constexpr int v_rd_off(int d0, int ks, int half) { return d0 * 512 + ks * 4096 + half * 2048; }
__device__ __forceinline__ int crow(int r, int hi) { return (r & 3) + 8 * (r >> 2) + 4 * hi; }
__device__ __forceinline__ unsigned cvtpk(float lo, float hi) { unsigned r; asm volatile("v_cvt_pk_bf16_f32 %0, %1, %2" : "=v"(r) : "v"(lo), "v"(hi)); return r; }
__device__ __forceinline__ void mask_tile(f32x16& p0, f32x16& p1, int dq) {
    const float NEG = -__builtin_inff();
#pragma unroll
    for (int r = 0; r < 16; ++r) {
        const int c = (r & 3) + 8 * (r >> 2);
        if ((unsigned)(dq - c) >= WBIG) p0[r] = NEG;
        if ((unsigned)(dq - c - 32) >= WBIG) p1[r] = NEG;
    }
}
constexpr float THR = 8.f;
__device__ __forceinline__ void partialSM(f32x16& p0, f32x16& p1, float& m_reg, float& mn, float& alpha) {
    constexpr float SCALE = MLA_SCALE;
    float pmax = p0[0];
#pragma unroll
    for (int r = 1; r < 16; ++r) pmax = fmaxf(pmax, p0[r]);
#pragma unroll
    for (int r = 0; r < 16; ++r) pmax = fmaxf(pmax, p1[r]);
    { auto rr = __builtin_amdgcn_permlane32_swap(__float_as_uint(pmax), __float_as_uint(pmax), false, false);
      pmax = fmaxf(__uint_as_float(rr[0]), __uint_as_float(rr[1])); }
    constexpr float C2 = LOG2E * SCALE;
    if (__builtin_expect(__all((pmax - m_reg) * SCALE <= THR), 1)) { mn = m_reg; alpha = 1.f; }
    else { mn = fmaxf(m_reg, pmax); alpha = __builtin_amdgcn_exp2f((m_reg - mn) * C2); m_reg = mn; }
    const float mnL = -mn * C2;
#pragma unroll
    for (int r = 0; r < 16; ++r) p0[r] = fmaf(p0[r], C2, mnL);
#pragma unroll
    for (int r = 0; r < 16; ++r) p1[r] = fmaf(p1[r], C2, mnL);
#pragma unroll
    for (int r = 0; r < 16; ++r) p0[r] = __builtin_amdgcn_exp2f(p0[r]);
}
#define PK4(P, B_, OUT) do { unsigned a0 = cvtpk(P[B_+0], P[B_+1]), a1 = cvtpk(P[B_+2], P[B_+3]);                          \
        unsigned b0 = cvtpk(P[B_+4], P[B_+5]), b1 = cvtpk(P[B_+6], P[B_+7]);                                             \
        auto r0 = __builtin_amdgcn_permlane32_swap(a0, b0, false, false); auto r1 = __builtin_amdgcn_permlane32_swap(a1, b1, false, false); \
        u32x4 w = {r0[0], r1[0], r0[1], r1[1]}; OUT = *reinterpret_cast<bf16x8*>(&w); } while (0)
__device__ __forceinline__ void finishSM(f32x16& p0, f32x16& p1, float alpha, float& l_reg, bf16x8& pa0, bf16x8& pa1, bf16x8& pa2, bf16x8& pa3) {
#pragma unroll
    for (int r = 0; r < 16; ++r) p1[r] = __builtin_amdgcn_exp2f(p1[r]);
    float ps = 0;
#pragma unroll
    for (int r = 0; r < 16; ++r) ps += p0[r];
#pragma unroll
    for (int r = 0; r < 16; ++r) ps += p1[r];
    { auto rr = __builtin_amdgcn_permlane32_swap(__float_as_uint(ps), __float_as_uint(ps), false, false);
      ps = __uint_as_float(rr[0]) + __uint_as_float(rr[1]); }
    l_reg = l_reg * alpha + ps;
    PK4(p0, 0, pa0); PK4(p0, 8, pa1); PK4(p1, 0, pa2); PK4(p1, 8, pa3);
}
constexpr float THR2 = 8.f * LOG2E;
__device__ __forceinline__ float max3f(float a, float b, float c) { return __builtin_fmaxf(__builtin_fmaxf(a, b), c); }
__device__ __forceinline__ void softmax_c(f32x16& p0, f32x16& p1, bool first, float& m_ref, f32x16& negm, float& l_reg, float& alpha, bf16x8& pa0, bf16x8& pa1, bf16x8& pa2, bf16x8& pa3) {
    float a = max3f(p0[0], p0[1], p1[0]), b = max3f(p0[2], p0[3], p1[1]); a = max3f(a, p1[2], p1[3]);
#pragma unroll
    for (int r = 4; r < 16; r += 4) { a = max3f(a, p0[r], p0[r + 1]); b = max3f(b, p0[r + 2], p0[r + 3]); a = max3f(a, p1[r], p1[r + 1]); b = max3f(b, p1[r + 2], p1[r + 3]); }
    float pmax = __builtin_fmaxf(a, b);
    { auto rr = __builtin_amdgcn_permlane32_swap(__float_as_uint(pmax), __float_as_uint(pmax), false, false);
      pmax = __builtin_fmaxf(__uint_as_float(rr[0]), __uint_as_float(rr[1])); }
    alpha = 1.f;
    if (__builtin_expect(first || __any(pmax > THR2), 0)) {
        const float dl = first ? pmax : __builtin_fmaxf(pmax, 0.f); m_ref += dl;
#pragma unroll
        for (int r = 0; r < 16; ++r) { p0[r] -= dl; p1[r] -= dl; }
#pragma unroll
        for (int r = 0; r < 16; ++r) negm[r] = -m_ref;
        alpha = first ? 1.f : __builtin_amdgcn_exp2f(-dl);
    }
#pragma unroll
    for (int r = 0; r < 16; ++r) { p0[r] = __builtin_amdgcn_exp2f(p0[r]); p1[r] = __builtin_amdgcn_exp2f(p1[r]); }
    float ps = 0;
#pragma unroll
    for (int r = 0; r < 16; ++r) ps += p0[r];
#pragma unroll
    for (int r = 0; r < 16; ++r) ps += p1[r];
    { auto rr = __builtin_amdgcn_permlane32_swap(__float_as_uint(ps), __float_as_uint(ps), false, false);
      ps = __uint_as_float(rr[0]) + __uint_as_float(rr[1]); }
    l_reg = l_reg * alpha + ps;
    PK4(p0, 0, pa0); PK4(p0, 8, pa1); PK4(p1, 0, pa2); PK4(p1, 8, pa3);
}
template <int KB, bool ROPE, int NREG = 8, bool CINIT = false>
__device__ __forceinline__ void qkt(f32x16& p0, f32x16& p1, const char* lds, int r32, int hi, const bf16x8* qr, const char* qpark = nullptr, const f32x16* cinit = nullptr) {
    if constexpr (!CINIT) { p0 = f32x16{}; p1 = f32x16{}; }
    int ysw = (hi * 16) ^ ((r32 & 15) << 4); asm volatile("" : "+v"(ysw));
    const char* krow = lds + kn_off(KB) + r32 * 256;
#pragma unroll
    for (int d0 = 0; d0 < 8; ++d0) { const char* a = krow + ((d0 * 32) ^ ysw);
        bf16x8 b0 = *reinterpret_cast<const bf16x8*>(a);
        bf16x8 b1 = *reinterpret_cast<const bf16x8*>(a + 32 * 256);
        bf16x8 qf; if (d0 < NREG) qf = qr[d0]; else qf = *reinterpret_cast<const bf16x8*>(qpark + (d0 - NREG) * 1024);
        if (CINIT && d0 == 0) { p0 = __builtin_amdgcn_mfma_f32_32x32x16_bf16(b0, qf, *cinit, 0, 0, 0); p1 = __builtin_amdgcn_mfma_f32_32x32x16_bf16(b1, qf, *cinit, 0, 0, 0); }
        else { p0 = __builtin_amdgcn_mfma_f32_32x32x16_bf16(b0, qf, p0, 0, 0, 0);
               p1 = __builtin_amdgcn_mfma_f32_32x32x16_bf16(b1, qf, p1, 0, 0, 0); } }
    if constexpr (ROPE) {
#pragma unroll
        for (int d0 = 0; d0 < 4; ++d0) { const char* a = lds + OFF_KR + KB * SHM_KR + KRSWZ(r32, (d0 * 16 + hi * 8) * 2);
            bf16x8 b0 = *reinterpret_cast<const bf16x8*>(a);
            bf16x8 b1 = *reinterpret_cast<const bf16x8*>(a + 32 * 128);
            bf16x8 qf; if (NREG >= 12) qf = qr[8 + d0]; else qf = *reinterpret_cast<const bf16x8*>(qpark + d0 * 1024);
            p0 = __builtin_amdgcn_mfma_f32_32x32x16_bf16(b0, qf, p0, 0, 0, 0);
            p1 = __builtin_amdgcn_mfma_f32_32x32x16_bf16(b1, qf, p1, 0, 0, 0); }
    }
}
template <int VB>
__device__ __forceinline__ void pv_tile(f32x16* o, int vb0, bf16x8 pa0, bf16x8 pa1, bf16x8 pa2, bf16x8 pa3) {
    const int vbx = VB == 2 ? vb0 + v_off(2) : vb0;
#define TRRD(dst, off) asm volatile("ds_read_b64_tr_b16 %0, %1 offset:%2" : "=&v"(dst) : "v"(vbx), "i"(off) : "memory")
#define PV_D0(d0) do { s16x4 l0, l1, l2, l3, h0, h1, h2, h3; constexpr int b_ = (VB == 2 ? 0 : v_off(VB)) + v_rd_off(d0, 0, 0); \
        TRRD(l0, b_); TRRD(h0, b_ + 2048); TRRD(l1, b_ + 4096); TRRD(h1, b_ + 6144); TRRD(l2, b_ + 8192); TRRD(h2, b_ + 10240); TRRD(l3, b_ + 12288); TRRD(h3, b_ + 14336); \
        asm volatile("s_waitcnt lgkmcnt(0)" ::: "memory"); SBAR();   \
        o[d0] = __builtin_amdgcn_mfma_f32_32x32x16_bf16(pa0, (bf16x8){l0[0], l0[1], l0[2], l0[3], h0[0], h0[1], h0[2], h0[3]}, o[d0], 0, 0, 0);   \
        o[d0] = __builtin_amdgcn_mfma_f32_32x32x16_bf16(pa1, (bf16x8){l1[0], l1[1], l1[2], l1[3], h1[0], h1[1], h1[2], h1[3]}, o[d0], 0, 0, 0);   \
        o[d0] = __builtin_amdgcn_mfma_f32_32x32x16_bf16(pa2, (bf16x8){l2[0], l2[1], l2[2], l2[3], h2[0], h2[1], h2[2], h2[3]}, o[d0], 0, 0, 0);   \
        o[d0] = __builtin_amdgcn_mfma_f32_32x32x16_bf16(pa3, (bf16x8){l3[0], l3[1], l3[2], l3[3], h3[0], h3[1], h3[2], h3[3]}, o[d0], 0, 0, 0); } while (0)
    PV_D0(0); PV_D0(1); PV_D0(2); PV_D0(3);
#undef PV_D0
#undef TRRD
}
#define VMW() asm volatile("s_waitcnt vmcnt(0)" ::: "memory")
__device__ __forceinline__ float silu_f(float z) { return z * __builtin_amdgcn_rcpf(1.0f + __builtin_amdgcn_exp2f(-LOG2E * z)); }
template <int CTRL> __device__ __forceinline__ float dpp_f(float v) { return __builtin_bit_cast(float, __builtin_amdgcn_update_dpp(0, __builtin_bit_cast(int, v), CTRL, 0xf, 0xf, true)); }
template <bool ALLOK>
__device__ __forceinline__ void store_o_t(const f32x16* o, const float* sc, bf16_t* Aw, const u32x4* zz, float* ssq, int qlo, int r32, int hi, char* stg) {
    const int lane = hi * 32 + r32, rr = lane >> 4, ch = lane & 15; const bool odd = (r32 & 1) != 0;
    float ss[16];
    char* sw = stg + ((odd ? 32 + r32 - 1 : r32) * 2);
#pragma unroll
    for (int r = 0; r < 16; ++r) { const int orow = crow(r, hi); float v[4]; ss[r] = 0.f;
#pragma unroll
        for (int d0 = 0; d0 < 4; ++d0) { v[d0] = o[d0][r] * sc[r]; ss[r] += v[d0] * v[d0]; }
#pragma unroll
        for (int dp = 0; dp < 4; dp += 2) { const float x0 = dpp_f<0xB1>(v[dp]), x1 = dpp_f<0xB1>(v[dp + 1]);
            *(unsigned*)(sw + orow * 256 + dp * 64) = odd ? cvtpk(x1, v[dp + 1]) : cvtpk(v[dp], x0); } }
#pragma unroll
    for (int r = 0; r < 16; ++r) ss[r] += dpp_f<0x128>(ss[r]);
#pragma unroll
    for (int r = 0; r < 16; ++r) ss[r] += dpp_f<0x124>(ss[r]);
#pragma unroll
    for (int r = 0; r < 16; ++r) ss[r] += dpp_f<0x122>(ss[r]);
#pragma unroll
    for (int r = 0; r < 16; ++r) ss[r] += dpp_f<0x121>(ss[r]);
    float sx[16];
#pragma unroll
    for (int r = 0; r < 16; ++r) sx[r] = __builtin_bit_cast(float, __builtin_amdgcn_ds_swizzle(__builtin_bit_cast(int, ss[r]), 0x401F));
    asm volatile("s_waitcnt lgkmcnt(0)" ::: "memory");
    if (r32 == 0) {
#pragma unroll
        for (int r = 0; r < 16; ++r) { const int orow = crow(r, hi); if (ALLOK || qlo + orow >= 0) ssq[(long)orow * 32] = ss[r] + sx[r]; } }
#pragma unroll
    for (int i = 0; i < 8; ++i) { const int row = 4 * i + rr; const u32x4 y = *(const u32x4*)(stg + row * 256 + ch * 16); const u32x4 z = zz[i]; u32x4 w;
#pragma unroll
        for (int e = 0; e < 4; ++e) { const float y0 = __builtin_bit_cast(float, y[e] << 16), y1 = __builtin_bit_cast(float, y[e] & 0xffff0000u);
            const float z0 = __builtin_bit_cast(float, z[e] << 16), z1 = __builtin_bit_cast(float, z[e] & 0xffff0000u); w[e] = cvtpk(y0 * silu_f(z0), y1 * silu_f(z1)); }
        if (ALLOK || qlo + row >= 0) *(u32x4*)(Aw + (long)row * LDO + ch * 8) = w; }
}
__device__ __forceinline__ void load_z(u32x4* zz, const bf16_t* Zw, int qlo, int lane) {
    const int rr = lane >> 4, ch = lane & 15;
#pragma unroll
    for (int i = 0; i < 8; ++i) zz[i] = (qlo + 4 * i + rr >= 0) ? *(const u32x4*)(Zw + (long)(4 * i + rr) * LDO + ch * 8) : (u32x4){0u, 0u, 0u, 0u};
}
__device__ __forceinline__ void store_o(const f32x16* o, const float* sc, bf16_t* Aw  , const u32x4* zz, float* ssq  , int qlo, int r32, int hi, char* stg) {
    if (qlo >= 0) store_o_t<true>(o, sc, Aw, zz, ssq, qlo, r32, hi, stg); else store_o_t<false>(o, sc, Aw, zz, ssq, qlo, r32, hi, stg);
}

__device__ __forceinline__ void mla_block(const bf16_t* Qh, const bf16_t* KNh, const bf16_t* KRh, const bf16_t* Vh, bf16_t* Oh, const bf16_t* Zh, float* ssq, int qb, char* lds) {
    int tid_ = threadIdx.x; asm volatile("" : "+v"(tid_));
    const int tid = tid_, wid = __builtin_amdgcn_readfirstlane(tid >> 6), lane = tid & 63, r32 = lane & 31, hi = lane >> 5;
    const int P0 = 256 * qb - 240, NT = 4 * qb + 1;
    const int qlo = P0 + wid * QBLK, qm = qlo + r32 - 4 * hi;
    float* ws = (float*)(lds + OFF_WS) + wid * 64; float* li_l = ws; float* al_l = ws + 32;
    float m_ref = 0.f, l_reg = 0; f32x16 o[4] = {}; f32x16 negm = {};
    const int vb0 = (int)(uintptr_t)lds + v_rd_base(lane);
    int gk0, gk1, gv0, gv1, gkr;
    { const int o0 = 1024 * (2 * wid) + 16 * lane, o1 = o0 + 1024;
      { const int row = o0 >> 8, cb = (o0 & 255) ^ ((row & 15) << 4); gk0 = row * LDK + (cb >> 1); }
      { const int row = o1 >> 8, cb = (o1 & 255) ^ ((row & 15) << 4); gk1 = row * LDK + (cb >> 1); }
      { const int sub = o0 >> 9, w_ = o0 & 511, kk = (sub >> 2) * 8 + (w_ >> 6), c = (sub & 3) * 32 + ((w_ & 63) >> 1), k = (kk & ~0xC) | ((kk & 4) << 1) | ((kk & 8) >> 1); gv0 = k * LDV + c; }
      { const int sub = o1 >> 9, w_ = o1 & 511, kk = (sub >> 2) * 8 + (w_ >> 6), c = (sub & 3) * 32 + ((w_ & 63) >> 1), k = (kk & ~0xC) | ((kk & 4) << 1) | ((kk & 8) >> 1); gv1 = k * LDV + c; }
      { const int o2 = 1024 * wid + 16 * lane, row = o2 >> 7, cb = (o2 & 127) ^ (((row >> 1) & 7) << 4); gkr = row * LDKR + (cb >> 1); } }
    ATT_LAS char* ldsl = (ATT_LAS char*)lds;
#define DMA16(gp, lo) __builtin_amdgcn_global_load_lds((const unsigned*)(gp), (ATT_LAS unsigned*)(ldsl + (lo)), 16, 0, 0)
#define SDMA(t, bf) do { const long k0_ = (long)(t) * KVBLK; \
        DMA16(Vh + k0_ * LDV + gv0, OFF_V + (bf) * SHM_V + 2048 * wid); DMA16(Vh + k0_ * LDV + gv1, OFF_V + (bf) * SHM_V + 2048 * wid + 1024); \
        DMA16(KNh + k0_ * LDK + gk0, OFF_KN + (bf) * SHM_KN + 2048 * wid); DMA16(KNh + k0_ * LDK + gk1, OFF_KN + (bf) * SHM_KN + 2048 * wid + 1024); \
        DMA16(KRh + k0_ * LDKR + gkr, OFF_KR + (bf) * SHM_KR + 1024 * wid); } while (0)
#define RESC(a) do { if (__any((a) < 1.f)) { if (hi == 0) al_l[r32] = (a); asm volatile("s_waitcnt lgkmcnt(0)" ::: "memory");              \
                     for (int d_ = 0; d_ < 4; ++d_) for (int r = 0; r < 16; ++r) o[d_][r] *= al_l[crow(r, hi)]; } } while (0)
#define MASKT(P0_, P1_, t) do { const int kb_ = (t) * KVBLK; if (kb_ + KVBLK - 1 > qlo) mask_tile(P0_, P1_, qm - kb_); } while (0)
    SDMA(0, 0);
    bf16x8 qr[12];
    { int qrow = qlo + r32; qrow = qrow < 0 ? 0 : qrow; const bf16_t* qp = Qh + (long)qrow * LDQM + hi * 8;
#pragma unroll
      for (int d0 = 0; d0 < 12; ++d0) qr[d0] = *(const bf16x8*)(qp + d0 * 16); }
    VMW();
    __syncthreads();
    f32x16 p0, p1; float al; bf16x8 pa0, pa1, pa2, pa3;
#define MLA_STEP(t, BUF) do { const int t_ = (t);                                                         \
        if (t_ + 1 < NT) { SDMA(t_ + 1, (BUF) ^ 1); SBAR(); }                                              \
        if (t_ * KVBLK <= qlo + QBLK - 1) {                                                                \
            qkt<BUF, true, 12, true>(p0, p1, lds, r32, hi, qr, nullptr, &negm);                            \
            MASKT(p0, p1, t_); softmax_c(p0, p1, t_ == 0, m_ref, negm, l_reg, al, pa0, pa1, pa2, pa3); RESC(al); SBAR();   \
            pv_tile<BUF>(o, vb0, pa0, pa1, pa2, pa3); }                                                   \
        VMW();                                                                                             \
        __syncthreads(); } while (0)
    for (int t = 0; t + 1 < NT; t += 2) { MLA_STEP(t, 0); MLA_STEP(t + 1, 1); }
    MLA_STEP(NT - 1, 0);
#undef MLA_STEP
    u32x4 zz[8]; load_z(zz, Zh + (long)qlo * LDO, qlo, lane);
    if (hi == 0) li_l[r32] = l_reg; asm volatile("s_waitcnt lgkmcnt(0)" ::: "memory");
    float rli[16];
#pragma unroll
    for (int r = 0; r < 16; ++r) rli[r] = __builtin_amdgcn_rcpf(li_l[crow(r, hi)]);
    store_o(o, rli, Oh + (long)qlo * LDO, zz, ssq + (long)qlo * 32, qlo, r32, hi, lds + wid * 8192);
    __syncthreads();
#undef MASKT
#undef RESC
#undef SDMA
#undef DMA16
}

__device__ __forceinline__ void sb_elem(f32x16& p0, f32x16& p1, float& carry, bool need_mask, int dq, bool hi0, bf16x8& pa0, bf16x8& pa1, bf16x8& pa2, bf16x8& pa3) {
    f32x16 m0, m1;
    { const f32x16 y0 = p0, y1 = p1; f32x16 e0, e1;
#pragma unroll
      for (int r = 0; r < 16; ++r) { e0[r] = __builtin_amdgcn_exp2f(__builtin_amdgcn_fmed3f(y0[r], 126.f, -__builtin_inff())); e1[r] = __builtin_amdgcn_exp2f(__builtin_amdgcn_fmed3f(y1[r], 126.f, -__builtin_inff())); }
      const f32x16 t0 = e0 + 1.0f, t1 = e1 + 1.0f;
#pragma unroll
      for (int r = 0; r < 16; ++r) { p0[r] = __builtin_amdgcn_rcpf(t0[r]); p1[r] = __builtin_amdgcn_rcpf(t1[r]); }
      m0 = e0 * p0; m1 = e1 * p1; }
    if (need_mask) {
#pragma unroll
        for (int r = 0; r < 16; ++r) { const int c = (r & 3) + 8 * (r >> 2);
            if ((unsigned)(dq - c) >= WBIG) { p0[r] = 0.f; m0[r] = 1.f; }
            if ((unsigned)(dq - c - 32) >= WBIG) { p1[r] = 0.f; m1[r] = 1.f; } }
    }
    float T[8], GH[8];
#pragma unroll
    for (int m = 0; m < 8; ++m) { const float g = m < 4 ? (m0[4 * m] * m0[4 * m + 1]) * (m0[4 * m + 2] * m0[4 * m + 3]) : (m1[4 * (m - 4)] * m1[4 * (m - 4) + 1]) * (m1[4 * (m - 4) + 2] * m1[4 * (m - 4) + 3]);
        auto rr = __builtin_amdgcn_permlane32_swap(__float_as_uint(g), __float_as_uint(g), false, false);
        T[m] = __uint_as_float(rr[0]) * __uint_as_float(rr[1]); GH[m] = __uint_as_float(rr[1]); }
    float SS = carry;
#pragma unroll
    for (int m = 7; m >= 0; --m) {
        const float t3 = SS * (hi0 ? GH[m] : 1.0f);
        if (m < 4) { const float t2 = t3 * m0[4 * m + 3], t1 = t2 * m0[4 * m + 2], t0 = t1 * m0[4 * m + 1];
            p0[4 * m + 3] *= t3; p0[4 * m + 2] *= t2; p0[4 * m + 1] *= t1; p0[4 * m] *= t0; }
        else { const int q = 4 * (m - 4); const float t2 = t3 * m1[q + 3], t1 = t2 * m1[q + 2], t0 = t1 * m1[q + 1];
            p1[q + 3] *= t3; p1[q + 2] *= t2; p1[q + 1] *= t1; p1[q] *= t0; }
        SS *= T[m];
    }
    carry = SS;
    PK4(p0, 0, pa0); PK4(p0, 8, pa1); PK4(p1, 0, pa2); PK4(p1, 8, pa3);
}
constexpr int OFF_SBFLAG = 131072 + 8192;
struct SbHalf { const bf16_t* Qh; const bf16_t* Kh; const bf16_t* Vh; const bf16_t* Zh; bf16_t* Oh; float* ssq; int hb; };
__device__ __forceinline__ void sb_block2(const SbHalf& HA, const SbHalf& HB, char* lds) {
    int tid_ = threadIdx.x; asm volatile("" : "+v"(tid_));
    const int tid = tid_, wid = __builtin_amdgcn_readfirstlane(tid >> 6), lane = tid & 63, r32 = lane & 31, hi = lane >> 5;
    const int g = wid >> 2, w4 = wid & 3;
    const bf16_t* Qh = g ? HB.Qh : HA.Qh; const bf16_t* Kh = g ? HB.Kh : HA.Kh; const bf16_t* Vh = g ? HB.Vh : HA.Vh; const bf16_t* Zh = g ? HB.Zh : HA.Zh;
    bf16_t* Oh = g ? HB.Oh : HA.Oh; float* ssq = g ? HB.ssq : HA.ssq; const int hb = g ? HB.hb : HA.hb;
    const int NT = 2 * hb + 1, smax = 2 * (HA.hb > HB.hb ? HA.hb : HB.hb) + 1;
    const int qlo = 128 * hb - 112 + w4 * QBLK, qm = qlo + r32 - 4 * hi - 1;
    char* lg = lds + g * 65536;
    f32x16 o[4] = {}; float carry = 1.f; const bool hi0 = hi == 0;
    const int vb0 = (int)(uintptr_t)lg + v_rd_base(lane);
    int gk[4], gv[4];
#pragma unroll
    for (int i = 0; i < 4; ++i) { const int o_ = 1024 * (4 * w4 + i) + 16 * lane;
      { const int row = o_ >> 8, cb = (o_ & 255) ^ ((row & 15) << 4); gk[i] = row * LDK + (cb >> 1); }
      { const int sub = o_ >> 9, w_ = o_ & 511, kk = (sub >> 2) * 8 + (w_ >> 6), c = (sub & 3) * 32 + ((w_ & 63) >> 1), k = (kk & ~0xC) | ((kk & 4) << 1) | ((kk & 8) >> 1); gv[i] = k * LDV + c; } }
    ATT_LAS char* ldsl = (ATT_LAS char*)lg;
#define DMA16(gp, lo) __builtin_amdgcn_global_load_lds((const unsigned*)(gp), (ATT_LAS unsigned*)(ldsl + (lo)), 16, 0, 0)
#define SDMA(t, bf) do { const long k0_ = (long)(t) * KVBLK; _Pragma("unroll") for (int i_ = 0; i_ < 4; ++i_) { \
        DMA16(Vh + k0_ * LDV + gv[i_], OFF_V + (bf) * SHM_V + 4096 * w4 + 1024 * i_); DMA16(Kh + k0_ * LDK + gk[i_], OFF_KN + (bf) * SHM_KN + 4096 * w4 + 1024 * i_); } } while (0)
    SDMA(NT - 1, 0);
    bf16x8 qr[8];
    { int qrow = qlo + r32; qrow = qrow < 0 ? 0 : qrow; const bf16_t* qp = Qh + (long)qrow * LDQS + hi * 8;
#pragma unroll
      for (int d0 = 0; d0 < 8; ++d0) qr[d0] = *(const bf16x8*)(qp + d0 * 16); }
    VMW();
    __syncthreads();
    f32x16 p0, p1; bf16x8 pa0, pa1, pa2, pa3;
    int* flags = (int*)(lds + OFF_SBFLAG); bool wdone = false, stop = false; const bool rowneg = qlo + r32 < 0;
#define SB_STEP(s, BUF) do { const int t_ = NT - 1 - (s); const int kb_ = t_ * KVBLK;     \
        if (t_ > 0) { SDMA(t_ - 1, (BUF) ^ 1); SBAR(); }                                                    \
        if (!wdone && t_ >= 0 && kb_ <= qlo + 30) {                                                         \
            qkt<BUF, false, 8>(p0, p1, lg, r32, hi, qr);                                                  \
            sb_elem(p0, p1, carry, kb_ + KVBLK - 1 >= qlo, qm - kb_, hi0, pa0, pa1, pa2, pa3); SBAR();    \
            pv_tile<BUF>(o, vb0, pa0, pa1, pa2, pa3);                                                     \
            wdone = __all(carry == 0.f || rowneg); }                                                      \
        if (lane == 0) flags[(BUF) * 8 + wid] = (wdone || t_ <= 0) ? 1 : 0;                                 \
        VMW();                                                                                              \
        __syncthreads();                                                                                    \
        { const int* f_ = flags + (BUF) * 8; const int a_ = f_[0] & f_[1] & f_[2] & f_[3] & f_[4] & f_[5] & f_[6] & f_[7];   \
          stop = __builtin_amdgcn_readfirstlane(a_) != 0; } } while (0)
    for (int s_ = 0; s_ < smax && !stop; s_ += 2) { SB_STEP(s_, 0); if (!stop && s_ + 1 < smax) SB_STEP(s_ + 1, 1); }
    u32x4 zz[8]; load_z(zz, Zh + (long)qlo * LDO, qlo, lane);
    float one[16];
#pragma unroll
    for (int r = 0; r < 16; ++r) one[r] = 1.f;
    store_o(o, one, Oh + (long)qlo * LDO, zz, ssq + (long)qlo * 32, qlo, r32, hi, lds + wid * 8192);
    __syncthreads();
#undef SB_STEP
#undef SDMA
#undef DMA16
}
#undef VMW
#undef PK4
#undef SBAR
#undef KSWZ
#undef KRSWZ
#undef ATT_LAS
}

constexpr int NWAVES = 8;
#ifndef MK_MULTI
#define MK_MULTI 0
#endif
constexpr int BATCH = 4, SEQ = 4096, DM = 4096, DEPTH = 4, NMETA = 16, SEQL = SEQ + NMETA;
constexpr int M = BATCH * SEQL;
constexpr int MP = 16640;
constexpr int QL = 1024, KVL = 512, NIN = 12032  , DIN = 11840, NUQ = 3072, NUKV = 4096;
constexpr float EPS = 1e-6f;
constexpr size_t MiB = 1u << 20;
constexpr size_t al2(size_t x) { return (x + 2 * MiB - 1) / (2 * MiB) * (2 * MiB); }
constexpr size_t WS_CTL = 0, CTL_ZERO_BYTES = 1 * MiB;
constexpr size_t WS_ROPE = 2 * MiB;
constexpr size_t WS_WIN = 4 * MiB;
constexpr size_t WS_WUQ = WS_WIN + al2((size_t)DEPTH * NIN * DM * 2);
constexpr size_t WS_WUKV = WS_WUQ + al2((size_t)DEPTH * NUQ * QL * 2);
constexpr size_t WS_WO = WS_WUKV + al2((size_t)DEPTH * NUKV * KVL * 2);
constexpr size_t WS_SSQ = WS_WO + al2((size_t)DEPTH * DM * DM * 2);
constexpr size_t WS_RSTD = WS_SSQ + al2((size_t)MP * 64 * 4);
constexpr size_t WS_U = WS_RSTD + al2((size_t)MP * 4);
constexpr size_t WS_SSQQ = WS_U + al2((size_t)MP * DM * 2);
constexpr size_t WS_SSQKV = WS_SSQQ + al2((size_t)MP * 16 * 4);
constexpr size_t WS_CQN = WS_SSQKV + al2((size_t)MP * 8 * 4);
constexpr size_t WS_CKVN = WS_CQN + al2((size_t)MP * QL * 2);
constexpr size_t WS_KR = WS_CKVN + al2((size_t)MP * KVL * 2);
constexpr size_t WS_Z = WS_KR + al2((size_t)MP * 64 * 2);
constexpr size_t WS_QSB = WS_Z + al2((size_t)MP * 4096 * 2);
constexpr size_t WS_KSB = WS_QSB + al2((size_t)MP * 2048 * 2);
constexpr size_t WS_VSB = WS_KSB + al2((size_t)MP * 2048 * 2);
constexpr size_t WS_QM = WS_VSB + al2((size_t)MP * 2048 * 2);
constexpr size_t WS_KM = WS_QM + al2((size_t)MP * 3072 * 2);
constexpr size_t WS_VM = WS_KM + al2((size_t)MP * 2048 * 2);
constexpr size_t WS_Y = WS_VM + al2((size_t)MP * 2048 * 2);
constexpr size_t WS_A = WS_Y + al2((size_t)MP * 4096 * 2);
constexpr size_t WS_SLAB = WS_A + al2((size_t)MP * 4096 * 2);
constexpr size_t WS_SSQY = WS_SLAB + al2((size_t)16 * 64 * 4096 * 4);
constexpr size_t WS_RATIO = WS_SSQY + al2((size_t)MP * 32 * 4);
constexpr size_t WS_RSB = WS_RATIO + al2((size_t)MP * 4);
constexpr size_t WS_END = WS_RSB + al2((size_t)MP * 4);
constexpr int MFULL = 16384;
constexpr int CW_BAR = 4096;
constexpr int RING_OFF = 0, RING_BYTES = 131072;
constexpr int LDSCTL_OFF = RING_BYTES, MISC_OFF = LDSCTL_OFF + 320;
constexpr int LDS_BYTES = 147456;
static_assert(att::ATT_LDS <= RING_BYTES && att::OFF_SBFLAG + 256 <= LDS_BYTES && att::OFF_SBFLAG >= LDSCTL_OFF + 4096, "attention LDS");

#define GAS __attribute__((address_space(1)))
#define LAS __attribute__((address_space(3)))
typedef unsigned short bf16;
typedef unsigned v4u __attribute__((ext_vector_type(4)));
typedef unsigned v2u __attribute__((ext_vector_type(2)));
typedef float f32x4 __attribute__((ext_vector_type(4)));
typedef GAS unsigned gu32;
#define RLX_AGENT __ATOMIC_RELAXED, __HIP_MEMORY_SCOPE_AGENT
#define LDS_WAIT() asm volatile("s_waitcnt lgkmcnt(0)" ::: "memory")
__device__ __forceinline__ unsigned f2bf(float f) { unsigned u = __builtin_bit_cast(unsigned, f); return (u + 0x7fffu + ((u >> 16) & 1u)) >> 16; }
__device__ __forceinline__ unsigned pk2(float lo, float hi) { return f2bf(lo) | (f2bf(hi) << 16); }
__device__ __forceinline__ float bflo(unsigned w) { return __builtin_bit_cast(float, w << 16); }
__device__ __forceinline__ float bfhi(unsigned w) { return __builtin_bit_cast(float, w & 0xffff0000u); }
#define XB_TMO      128
#define XB_XCNT(j)  (256  + 64 * (j))
#define XB_XSUB(j)  (1280 + 64 * (j))
#define XB_XGEN(j)  (2304 + 64 * (j))
#define XB_TOP      3328
#define XB_TOPGEN   3392
#define XCD_BAR_WORDS 3456
#define XB_SPIN_CAP (1u << 18)

__device__ __forceinline__ unsigned xb_ld(unsigned* p)              { return __hip_atomic_load(p, __ATOMIC_RELAXED, __HIP_MEMORY_SCOPE_AGENT); }
__device__ __forceinline__ unsigned xb_add(unsigned* p, unsigned v) { return __hip_atomic_fetch_add(p, v, __ATOMIC_RELAXED, __HIP_MEMORY_SCOPE_AGENT); }
__device__ __forceinline__ unsigned xb_xcc_id() { return (unsigned)__builtin_amdgcn_s_getreg((3 << 11) | 20) & 0xFu; }
#define XB_SPIN(cond, bar) do { unsigned _sp = 0; while (cond) { __builtin_amdgcn_s_sleep(1); \
    if ((++_sp & 255u) == 0u) { if (xb_ld(&(bar)[XB_TMO])) break; if (_sp > XB_SPIN_CAP) { atomicAdd(&(bar)[XB_TMO], 1u); break; } } } } while (0)

struct XcdBarrier {
    unsigned* bar; unsigned x;
    volatile LAS unsigned* st;
};

__device__ __forceinline__ XcdBarrier xcd_barrier_post(unsigned* bar, volatile LAS unsigned* st) {
    XcdBarrier b; b.bar = bar; b.x = xb_xcc_id(); b.st = st;
    if (threadIdx.x == 0) (void)xb_add(&bar[XB_XCNT(b.x)], 1u);
    return b;
}
__device__ __forceinline__ void xcd_barrier_complete(unsigned* bar, unsigned x, unsigned& nloc, unsigned& nx) {
    const unsigned G = gridDim.x * gridDim.y * gridDim.z;
    unsigned sum, cnt, mine, sp = 0u;
    for (;;) {
        sum = 0u; cnt = 0u; mine = 0u;
#pragma unroll
        for (unsigned j = 0; j < 16; ++j) { const unsigned c = xb_ld(&bar[XB_XCNT(j)]); sum += c; cnt += (c > 0u) ? 1u : 0u; mine = (j == x) ? c : mine; }
        if (sum == G) break;
        __builtin_amdgcn_s_sleep(1);
        if ((++sp & 255u) == 0u) { if (xb_ld(&bar[XB_TMO])) break; if (sp > XB_SPIN_CAP) { atomicAdd(&bar[XB_TMO], 1u); break; } }
    }
    nloc = mine > 0u ? mine : 1u; nx = cnt > 0u ? cnt : 1u;
}

__device__ __forceinline__ void xcd_barrier(const XcdBarrier& b) {
    asm volatile("s_waitcnt vmcnt(0)" ::: "memory");
    __syncthreads();
    if (threadIdx.x == 0) {
        unsigned* bar = b.bar;
        __builtin_amdgcn_s_waitcnt(0);
        unsigned nloc = b.st[0], nx = b.st[1];
        if (nloc == 0u) { xcd_barrier_complete(bar, b.x, nloc, nx); b.st[0] = nloc; b.st[1] = nx; }
        const unsigned old = xb_add(&bar[XB_XSUB(b.x)], 1u);
        const unsigned gen = old / nloc;
        if (old + 1u == (gen + 1u) * nloc) {
            __builtin_amdgcn_fence(__ATOMIC_RELEASE, "agent");
            asm volatile("s_waitcnt vmcnt(0)" ::: "memory");
            const unsigned og = xb_add(&bar[XB_TOP], 1u);
            const unsigned tg = og / nx;
            if (og + 1u == (tg + 1u) * nx) xb_add(&bar[XB_TOPGEN], 1u);
            else XB_SPIN(xb_ld(&bar[XB_TOPGEN]) == tg, bar);
            __builtin_amdgcn_fence(__ATOMIC_ACQUIRE, "agent");
            xb_add(&bar[XB_XGEN(b.x)], 1u);
            asm volatile("s_waitcnt vmcnt(0)" ::: "memory");
        } else {
            XB_SPIN(xb_ld(&bar[XB_XGEN(b.x)]) == gen, bar);
            __builtin_amdgcn_fence(__ATOMIC_ACQUIRE, "agent");
            asm volatile("s_waitcnt vmcnt(0)" ::: "memory");
        }
    }
    __syncthreads();
}

struct Frame {
    LAS unsigned char* lds;
    volatile LAS unsigned* MISC;
    gu32* ctl;
    int tid, lane, wave, vcu, G;
};
__device__ __forceinline__ float wave_sum(float v) {
#pragma unroll
    for (int o = 1; o < 64; o <<= 1) v += __shfl_xor(v, o);
    return v;
}
__device__ __forceinline__ void transpose_item(const float* W, int N, int K, bf16* WT, int src_col0, int dst_row0, int k0, LAS float* scr, int lane, const float* gk) {
    float tv[32];
#pragma unroll
    for (int i = 0; i < 32; ++i) { const int kk = 2 * i + (lane >> 5); tv[i] = W[(size_t)(k0 + kk) * N + src_col0 + (lane & 31)]; }
#pragma unroll
    for (int i = 0; i < 32; ++i) { const int kk = 2 * i + (lane >> 5); scr[kk * 33 + (lane & 31)] = gk ? tv[i] * gk[k0 + kk] : tv[i]; }
    LDS_WAIT(); asm volatile("" ::: "memory");
    const int c = lane & 7;
#pragma unroll
    for (int j = 0; j < 4; ++j) { const int n = (lane >> 3) + 8 * j; const LAS float* s = scr + (8 * c) * 33 + n;
        v4u o; o.x = pk2(s[0 * 33], s[1 * 33]); o.y = pk2(s[2 * 33], s[3 * 33]); o.z = pk2(s[4 * 33], s[5 * 33]); o.w = pk2(s[6 * 33], s[7 * 33]);
        *(GAS v4u*)(WT + (size_t)(dst_row0 + n) * K + k0 + 8 * c) = o; }
    LDS_WAIT(); asm volatile("" ::: "memory");
}
template <int MODE>
__device__ __forceinline__ void h_row(const float* src, bf16* HB, int row, bool tail, const float* slab, float* RSTD, const float* g, float* out, int lane) {
    f32x4 v[8][2];
    if (MODE == 0) { const GAS f32x4* sr = (const GAS f32x4*)src + 2 * lane;
#pragma unroll
        for (int j = 0; j < 8; ++j) { v[j][0] = sr[128 * j]; v[j][1] = sr[128 * j + 1]; } }
    else { const GAS v4u* hr = (const GAS v4u*)(HB + (size_t)row * DM) + lane;
#pragma unroll
        for (int j = 0; j < 8; ++j) { const v4u h = hr[64 * j]; v[j][0] = (f32x4){bflo(h.x), bfhi(h.x), bflo(h.y), bfhi(h.y)}; v[j][1] = (f32x4){bflo(h.z), bfhi(h.z), bflo(h.w), bfhi(h.w)}; }
        if (tail) for (int s = 0; s < 16; ++s) { const GAS f32x4* pr = (const GAS f32x4*)(slab + ((size_t)s * 64 + (row - MFULL)) * DM) + 2 * lane;
#pragma unroll
            for (int j = 0; j < 8; ++j) { v[j][0] += pr[128 * j]; v[j][1] += pr[128 * j + 1]; } } }
    float ss = 0.f;
    if (MODE != 2) {
        GAS v4u* hw = (GAS v4u*)(HB + (size_t)row * DM) + lane;
#pragma unroll
        for (int j = 0; j < 8; ++j) { v4u w; w.x = pk2(v[j][0].x, v[j][0].y); w.y = pk2(v[j][0].z, v[j][0].w); w.z = pk2(v[j][1].x, v[j][1].y); w.w = pk2(v[j][1].z, v[j][1].w);
            if (MODE == 0 || tail) hw[64 * j] = w;
#pragma unroll
            for (int e = 0; e < 4; ++e) { const float a = bflo(w[e]), b = bfhi(w[e]); ss += a * a + b * b; } }
        const float rstd = 1.0f / sqrtf(wave_sum(ss) * (1.0f / DM) + EPS);
        if (lane == 0) RSTD[row] = rstd;
    } else {
#pragma unroll
        for (int j = 0; j < 8; ++j) ss += (v[j][0].x * v[j][0].x + v[j][0].y * v[j][0].y) + (v[j][0].z * v[j][0].z + v[j][0].w * v[j][0].w) + (v[j][1].x * v[j][1].x + v[j][1].y * v[j][1].y) + (v[j][1].z * v[j][1].z + v[j][1].w * v[j][1].w);
        const float rstd = 1.0f / sqrtf(wave_sum(ss) * (1.0f / DM) + EPS);
        const int b = row / SEQL, t = row % SEQL;
        GAS f32x4* orow = (GAS f32x4*)(out + ((size_t)b * SEQ + (t - NMETA)) * DM) + 2 * lane; const GAS f32x4* gr = (const GAS f32x4*)g + 2 * lane;
#pragma unroll
        for (int j = 0; j < 8; ++j) { orow[128 * j] = (v[j][0] * rstd) * gr[128 * j]; orow[128 * j + 1] = (v[j][1] * rstd) * gr[128 * j + 1]; }
    }
}
template <int MODE>
__device__ __forceinline__ void h_rows(Frame& F, const float* x, const float* meta, bf16* HB, const float* slab, const float* SSQ, float* RSTD, const float* g, float* out) {
    const int gw = F.vcu * NWAVES + F.wave, NGW = F.G * NWAVES; int lane = F.lane; asm volatile("" : "+v"(lane));
    if (MODE == 0) {
        for (int row = gw; row < MP; row += NGW) {
            if (row >= M) { GAS v4u* hw = (GAS v4u*)(HB + (size_t)row * DM) + lane;
#pragma unroll
                for (int j = 0; j < 8; ++j) hw[64 * j] = (v4u){0u, 0u, 0u, 0u};
                if (lane == 0) RSTD[row] = 0.f;
                continue; }
            const int b = row / SEQL, t = row % SEQL;
            h_row<0>(t < NMETA ? meta + (size_t)t * DM : x + ((size_t)b * SEQ + (t - NMETA)) * DM, HB, row, false, nullptr, RSTD, nullptr, nullptr, lane);
        }
    } else {
        for (int i4 = F.vcu; i4 < (M - MFULL) * 4; i4 += F.G) if ((i4 & 3) == 0) {
            const int row = MFULL + (i4 >> 2), col = 512 * F.wave + 8 * lane;
            const v4u hv = *(const GAS v4u*)(HB + (size_t)row * DM + col);
            f32x4 a0 = (f32x4){bflo(hv.x), bfhi(hv.x), bflo(hv.y), bfhi(hv.y)}, a1 = (f32x4){bflo(hv.z), bfhi(hv.z), bflo(hv.w), bfhi(hv.w)};
            f32x4 s0[16], s1[16];
#pragma unroll
            for (int s = 0; s < 16; ++s) { const GAS f32x4* pr = (const GAS f32x4*)(slab + ((size_t)s * 64 + (row - MFULL)) * DM + col); s0[s] = pr[0]; s1[s] = pr[1]; }
#pragma unroll
            for (int s = 0; s < 16; ++s) { a0 += s0[s]; a1 += s1[s]; }
            float ss;
            if (MODE == 1) { v4u w; w.x = pk2(a0.x, a0.y); w.y = pk2(a0.z, a0.w); w.z = pk2(a1.x, a1.y); w.w = pk2(a1.z, a1.w);
                *(GAS v4u*)(HB + (size_t)row * DM + col) = w; ss = 0.f;
#pragma unroll
                for (int e = 0; e < 4; ++e) { const float p = bflo(w[e]), q = bfhi(w[e]); ss += p * p + q * q; } }
            else ss = (a0.x * a0.x + a0.y * a0.y) + (a0.z * a0.z + a0.w * a0.w) + (a1.x * a1.x + a1.y * a1.y) + (a1.z * a1.z + a1.w * a1.w);
            ss = wave_sum(ss);
            LAS float* red = (LAS float*)(F.lds + RING_OFF);
            if (lane == 0) red[F.wave] = ss;
            __syncthreads();
            float tot = 0.f;
#pragma unroll
            for (int w = 0; w < NWAVES; ++w) tot += red[w];
            const float rstd = 1.0f / sqrtf(tot * (1.0f / DM) + EPS);
            if (MODE == 1) { if (F.wave == 0 && lane == 0) RSTD[row] = rstd; }
            else { const int b = row / SEQL, t = row % SEQL; GAS f32x4* orow = (GAS f32x4*)(out + ((size_t)b * SEQ + (t - NMETA)) * DM + col); const GAS f32x4* gr = (const GAS f32x4*)(g + col);
                orow[0] = (a0 * rstd) * gr[0]; orow[1] = (a1 * rstd) * gr[1]; }
            __syncthreads();
        }
        if (MODE == 1) {
            for (int r4 = gw * 4; r4 < MFULL; r4 += NGW * 4) { const int row = r4 + (lane >> 4);
                const f32x4 v = *(const GAS f32x4*)(SSQ + (size_t)row * 64 + (lane & 15) * 4); float s = (v.x + v.y) + (v.z + v.w);
                s += __shfl_xor(s, 1); s += __shfl_xor(s, 2); s += __shfl_xor(s, 4); s += __shfl_xor(s, 8);
                if ((lane & 15) == 0) RSTD[row] = 1.0f / sqrtf(s * (1.0f / DM) + EPS); }
        } else {
            for (int row = gw; row < MFULL; row += NGW) { if (row % SEQL < NMETA) continue; h_row<2>(nullptr, HB, row, false, slab, RSTD, g, out, lane); }
        }
    }
}
__device__ __forceinline__ void p0_prologue(Frame& F, const float* const* in, unsigned char* ws) {
    LAS float* scr = (LAS float*)(F.lds + RING_OFF + F.wave * 16384);
    const int gw = F.vcu * NWAVES + F.wave, NGW = F.G * NWAVES;
    const float *w_in = in[3], *w_uq = in[6], *w_ukv = in[7], *w_o = in[10];
    bf16* Win_t = (bf16*)(ws + WS_WIN); bf16* Wuq_t = (bf16*)(ws + WS_WUQ); bf16* Wukv_t = (bf16*)(ws + WS_WUKV); bf16* Wo_t = (bf16*)(ws + WS_WO);
    constexpr int C_IN = 64 * 370, C_UQ = 16 * 96, C_UKV = 8 * 128, C_WO = 64 * 128, C_L = C_IN + C_UQ + C_UKV + C_WO;
    for (int it = gw; it < DEPTH * C_L; it += NGW) {
        const int l = it / C_L; int r = it % C_L;
        if (r < C_IN) { const int kb = r / 370, sb = r % 370, src = 32 * sb; const int dst = src < 1536 ? src : (src == 1536 ? 1536 : (src == 1568 ? 1664 : src + 192));
            transpose_item(w_in + (size_t)l * DM * DIN, DIN, DM, Win_t + (size_t)l * NIN * DM, src, dst, 64 * kb, scr, F.lane, in[2] + (size_t)l * DM); continue; }
        r -= C_IN;
        if (r < C_UQ) { const int kb = r / 96, sb = r % 96, hd = sb / 6, jb = sb % 6; const int dst = jb < 4 ? hd * 128 + jb * 32 : (8 + hd / 4) * 256 + (jb - 4) * 128 + (hd % 4) * 32;
            transpose_item(w_uq + (size_t)l * QL * NUQ, NUQ, QL, Wuq_t + (size_t)l * NUQ * QL, 32 * sb, dst, 64 * kb, scr, F.lane, in[4] + (size_t)l * QL); continue; }
        r -= C_UQ;
        if (r < C_UKV) { const int kb = r / 128, sb = r % 128, hd = sb / 8, jb = sb % 8; const int dst = jb < 4 ? hd * 128 + jb * 32 : 2048 + hd * 128 + (jb - 4) * 32;
            transpose_item(w_ukv + (size_t)l * KVL * NUKV, NUKV, KVL, Wukv_t + (size_t)l * NUKV * KVL, 32 * sb, dst, 64 * kb, scr, F.lane, in[5] + (size_t)l * KVL); continue; }
        r -= C_UKV;
        { const int kb = r / 128, sb = r % 128; transpose_item(w_o + (size_t)l * DM * DM, DM, DM, Wo_t + (size_t)l * DM * DM, 32 * sb, 32 * sb, 64 * kb, scr, F.lane, kb < 32 ? in[8] + (size_t)l * 2048 : in[9] + (size_t)l * 2048 - 2048); }
    }
    const int gtid = F.vcu * (NWAVES * 64) + F.tid, NT = F.G * NWAVES * 64;
    for (int idx = gtid; idx < DEPTH * 192 * 512; idx += NT) {
        const int l = idx / (192 * 512), r = idx % (192 * 512), row = r / 512, c16 = r % 512, drow = row < 96 ? 1568 + row : 1696 + (row - 96);
        *(GAS v4u*)(Win_t + ((size_t)l * NIN + drow) * DM + c16 * 8) = (v4u){0u, 0u, 0u, 0u}; }
    for (int idx = gtid; idx < (MP - M) * 512; idx += NT) *(GAS v4u*)((bf16*)(ws + WS_A) + (size_t)M * 4096 + (size_t)idx * 8) = (v4u){0u, 0u, 0u, 0u};
    float* rope = (float*)(ws + WS_ROPE);
    for (int idx = gtid; idx < SEQL * 32; idx += NT) { const int pos = idx >> 5, i = idx & 31;
        const float inv = powf(10000.0f, -(float)(2 * i) / 64.0f), ang = (float)pos * inv;
        rope[pos * 64 + i] = cosf(ang); rope[pos * 64 + 32 + i] = sinf(ang); }
    h_rows<0>(F, in[0], in[1], (bf16*)(ws + WS_U), nullptr, nullptr, (float*)(ws + WS_RSTD), nullptr, nullptr);
}

struct Args { const float* in[12]; float* out; unsigned char* ws; int ph_lo, ph_hi; };
constexpr int NPH = 1 + 7 * DEPTH;
__global__ void __launch_bounds__(NWAVES * 64, 2) hymba_fwd(Args args) {
    extern __shared__ __attribute__((aligned(16))) unsigned char lds[];
    Frame F;
    F.lds = (LAS unsigned char*)lds;
    F.MISC = (volatile LAS unsigned*)(F.lds + MISC_OFF);
    F.tid = threadIdx.x; F.lane = F.tid & 63; F.wave = __builtin_amdgcn_readfirstlane(F.tid >> 6);
    F.G = gridDim.x; { const int bx = blockIdx.x; F.vcu = (F.G % 8 == 0) ? (bx % 8) * (F.G / 8) + bx / 8 : bx; }
    unsigned char* ws = args.ws;
    F.ctl = (gu32*)(ws + WS_CTL);
    for (int u = F.tid; u < (LDS_BYTES - LDSCTL_OFF) / 4; u += NWAVES * 64) ((LAS unsigned*)(F.lds + LDSCTL_OFF))[u] = 0u;
    __syncthreads();
    XcdBarrier bar; bar.bar = (unsigned*)(F.ctl + CW_BAR); bar.x = 0; bar.st = nullptr;
    if (!MK_MULTI) bar = xcd_barrier_post((unsigned*)(F.ctl + CW_BAR), F.MISC + 8);
    const int lo = args.ph_lo, hi = args.ph_hi;
#ifndef PHMASK
#define PHMASK 0x1ff
#endif
#define EN(t) (((PHMASK) >> (t)) & 1)
#define IN(k) (lo <= (k) && (k) < hi)
#ifndef REP_BAR
#define REP_BAR 1
#endif
#define GRID_BAR(k) do { if (IN((k) + 1)) { if (!MK_MULTI) for (int rb_ = 0; rb_ < REP_BAR; ++rb_) xcd_barrier(bar); } } while (0)
#define WSL_() GAS unsigned char* wsl = (GAS unsigned char*)ws; asm volatile("" : "+s"(wsl))
#define U ((bf16*)(wsl + WS_U))
#define SSQ ((float*)(wsl + WS_SSQ))
#define RSTD ((float*)(wsl + WS_RSTD))
#define SSQY ((float*)(wsl + WS_SSQY))
#define RATIO ((float*)(wsl + WS_RATIO))
#define RSB ((float*)(wsl + WS_RSB))
#define SSQQ ((float*)(wsl + WS_SSQQ))
#define SSQKV ((float*)(wsl + WS_SSQKV))
#define CQN ((bf16*)(wsl + WS_CQN))
#define CKVN ((bf16*)(wsl + WS_CKVN))
#define KR ((bf16*)(wsl + WS_KR))
#define Zb ((bf16*)(wsl + WS_Z))
#define QSB ((bf16*)(wsl + WS_QSB))
#define KSB ((bf16*)(wsl + WS_KSB))
#define VSB ((bf16*)(wsl + WS_VSB))
#define QM ((bf16*)(wsl + WS_QM))
#define KM ((bf16*)(wsl + WS_KM))
#define VM ((bf16*)(wsl + WS_VM))
#define A ((bf16*)(wsl + WS_A))
#define rope ((const float*)(wsl + WS_ROPE))

    #ifndef REP_THIN
#define REP_THIN 1
#endif
    if (EN(0) && IN(0)) { for (int rep = 0; rep < REP_THIN; ++rep) p0_prologue(F, args.in, ws); GRID_BAR(0); }
    for (int l = 0; l < DEPTH; ++l) {
        const int pb = 1 + 7 * l;
        if (EN(1) && IN(pb)) {
            WSL_();
            pg8::Gemm g{U, (const bf16*)(wsl + WS_WIN) + (size_t)l * NIN * DM, MP, NIN, DM}; pg8::InAOrder S{F.G, (int)blockIdx.x};
            pg8::EpiIn E{CQN, CKVN, SSQQ, SSQKV, KR, Zb, QSB, KSB, VSB, rope, RSTD};
            pg8::gemm_phase<pg8::EpiIn, pg8::InAOrder, true, true>(F.lds + RING_OFF, g, S, E);
            if (!MK_MULTI) { asm volatile("s_waitcnt vmcnt(0)" ::: "memory"); __syncthreads();
                if (threadIdx.x == 0) { __builtin_amdgcn_fence(__ATOMIC_RELEASE, "agent"); asm volatile("s_waitcnt vmcnt(0)" ::: "memory");
                    (void)__hip_atomic_fetch_add((GAS unsigned*)(wsl + WS_CTL) + 3072 + 32 * l, 1u, __ATOMIC_RELAXED, __HIP_MEMORY_SCOPE_AGENT); } }
        }
        if (EN(3) && IN(pb + 2)) {
            WSL_();
            { pg8::Gemm g{U, (const bf16*)(wsl + WS_WIN) + (size_t)l * NIN * DM, MP, NIN, DM}; pg8::InBOrder S{F.G, (int)blockIdx.x};
              pg8::EpiIn E{CQN, CKVN, SSQQ, SSQKV, KR, Zb, QSB, KSB, VSB, rope, RSTD};
              pg8::gemm_phase<pg8::EpiIn, pg8::InBOrder, true, true>(F.lds + RING_OFF, g, S, E); }
            if (!MK_MULTI) {
                if (threadIdx.x == 0) { GAS unsigned* pc_ = (GAS unsigned*)(wsl + WS_CTL) + 3072 + 32 * l; unsigned sp_ = 0;
                    while (__hip_atomic_load(pc_, __ATOMIC_RELAXED, __HIP_MEMORY_SCOPE_AGENT) < (unsigned)F.G) { __builtin_amdgcn_s_sleep(2); if (++sp_ > (1u << 20)) break; }
                    __builtin_amdgcn_fence(__ATOMIC_ACQUIRE, "agent"); asm volatile("s_waitcnt vmcnt(0)" ::: "memory"); }
                __syncthreads(); }
            { pg8::Gemm g{CQN, (const bf16*)(wsl + WS_WUQ) + (size_t)l * NUQ * QL, MP, NUQ, QL}; pg8::StaticOrder S; S.init(MP, NUQ, F.G, (int)(F.G - 1 - blockIdx.x));
              pg8::EpiUq E{QM, rope, SSQQ};
              pg8::gemm_phase<pg8::EpiUq, pg8::StaticOrder, true, true>(F.lds + RING_OFF, g, S, E); }
            { pg8::Gemm g{CKVN, (const bf16*)(wsl + WS_WUKV) + (size_t)l * NUKV * KVL, MP, NUKV, KVL};
              pg8::DynOrder S{(GAS unsigned*)(wsl + WS_CTL) + 64 + 16 * l, (volatile LAS unsigned*)(F.lds + LDSCTL_OFF + 4096), MP / 256, NUKV / 256, (MP / 256) * (NUKV / 256), 2, F.G, (int)blockIdx.x};
              pg8::EpiUkv E{KM, VM, SSQKV};
              pg8::gemm_phase<pg8::EpiUkv, pg8::DynOrder, true, true>(F.lds + RING_OFF, g, S, E); }
            GRID_BAR(pb + 2);
        }
        if (IN(pb + 3)) {
            WSL_(); char* al = (char*)lds + RING_OFF;
            const int npair = (512 - F.vcu + F.G - 1) / F.G;
            const int m0a = F.vcu, m0b = (F.vcu + F.G - 64 % F.G) % F.G;
            const int nmeta_a = m0a < 64 ? (63 - m0a) / F.G + 1 : 0, nmeta_b = m0b < 64 ? (63 - m0b) / F.G + 1 : 0;
#ifndef REP_MLA
#define REP_MLA 1
#endif
            if (EN(4)) for (int rep = 0; rep < REP_MLA; ++rep) {
#pragma clang loop unroll(disable)
                for (int j = 0; j < 2 * npair + nmeta_a; ++j) {
                    int bh, qb;
                    if (j < 2 * npair) { const int item = F.vcu + F.G * (j >> 1), p = item & 7; bh = item >> 3; qb = (j & 1) ? 1 + p : 16 - p; }
                    else { bh = m0a + F.G * (j - 2 * npair); qb = 0; }
                    const size_t row0 = (size_t)(bh >> 4) * SEQL; const int hd = bh & 15;
                    att::mla_block(QM + row0 * 3072 + hd * 192, KM + row0 * 2048 + hd * 128, KR + row0 * 64, VM + row0 * 2048 + hd * 128, A + row0 * 4096 + hd * 128, Zb + row0 * 4096 + hd * 128, SSQY + row0 * 32 + hd, qb, al);
                }
            }
#ifndef REP_SB
#define REP_SB 1
#endif
            if (EN(5)) {
                const int dyn0 = 2 * F.G < 1024 ? 2 * F.G : 1024; int js = 0, nextdyn = 0;
                volatile LAS unsigned* slot = (volatile LAS unsigned*)(F.lds + LDSCTL_OFF + 4096 + 64);
                GAS unsigned* sbctr = (GAS unsigned*)(wsl + WS_CTL) + 2048 + 32 * l;
                int t0_ = threadIdx.x; asm volatile("" : "+v"(t0_)); const int w0_ = __builtin_amdgcn_readfirstlane(t0_ >> 6);
                if (!(F.vcu < dyn0)) {
                    if (t0_ == 0) slot[0] = __hip_atomic_fetch_add(sbctr, 1u, __ATOMIC_RELAXED, __HIP_MEMORY_SCOPE_AGENT);
                    __syncthreads(); nextdyn = __builtin_amdgcn_readfirstlane((int)slot[0]); }
#pragma clang loop unroll(disable)
                for (;;) {
                    int item;
                    if (js < 2 && F.vcu + F.G * js < dyn0) { item = F.vcu + F.G * js; ++js; }
                    else { js = 2; item = dyn0 + nextdyn; if (item >= 1024 + 32) break; }
                    const bool ndyn = !(js < 2 && F.vcu + F.G * js < dyn0);
                    unsigned pend_ = 0;
                    if (ndyn && w0_ == 0) asm volatile("s_mov_b64 exec, 1\n\tglobal_atomic_add %0, %1, %2, off sc0\n\ts_mov_b64 exec, -1" : "=v"(pend_) : "v"(sbctr), "v"(1u) : "memory");
                    const bool meta = item >= 1024; if (meta) item -= 1024;
                    const int ppq = 15 - (item >> 6);
                    const int bhA = meta ? 2 * item : item & 63, bhB = meta ? 2 * item + 1 : bhA, hbA = meta ? 0 : 2 * ppq + 1, hbB = meta ? 0 : hbA + 1;
                    const size_t rA = (size_t)(bhA >> 4) * SEQL, rB = (size_t)(bhB >> 4) * SEQL; const int hA = bhA & 15, hB = bhB & 15;
                    const att::SbHalf HA{QSB + rA * 2048 + hA * 128, KSB + rA * 2048 + hA * 128, VSB + rA * 2048 + hA * 128, Zb + rA * 4096 + 2048 + hA * 128, A + rA * 4096 + 2048 + hA * 128, SSQY + rA * 32 + 16 + hA, hbA};
                    const att::SbHalf HB{QSB + rB * 2048 + hB * 128, KSB + rB * 2048 + hB * 128, VSB + rB * 2048 + hB * 128, Zb + rB * 4096 + 2048 + hB * 128, A + rB * 4096 + 2048 + hB * 128, SSQY + rB * 32 + 16 + hB, hbB};
                    att::sb_block2(HA, HB, al);
                    if (ndyn) { if (w0_ == 0) { asm volatile("s_waitcnt vmcnt(0)" ::: "memory"); if (t0_ == 0) slot[0] = pend_; }
                        __syncthreads(); nextdyn = __builtin_amdgcn_readfirstlane((int)slot[0]); }
                }
            }
            GRID_BAR(pb + 3);
        }
        if (EN(7) && IN(pb + 5)) {
            WSL_();
            LAS float* ytab = (LAS float*)(F.lds + LDSCTL_OFF + 1024);
#define FILL_YTAB(pm_) do { int t0_ = F.tid; asm volatile("" : "+v"(t0_)); for (int r_ = t0_; r_ < 256; r_ += NWAVES * 64) { const int row_ = (pm_) * 256 + r_; float ra_ = 0.f, rb_ = 0.f;                                  \
                if (row_ < M) { const GAS f32x4* sp_ = (const GAS f32x4*)(SSQY + (size_t)row_ * 32); float s1_ = 0.f, s2_ = 0.f;                                                  \
                    _Pragma("unroll") for (int j_ = 0; j_ < 4; ++j_) { const f32x4 a_ = sp_[j_], b_ = sp_[4 + j_]; s1_ += (a_.x + a_.y) + (a_.z + a_.w); s2_ += (b_.x + b_.y) + (b_.z + b_.w); } \
                    const float r1_ = 1.0f / sqrtf(s1_ * (1.0f / 2048) + EPS), r2_ = 1.0f / sqrtf(s2_ * (1.0f / 2048) + EPS); ra_ = r1_ / r2_; rb_ = r2_; }                     \
                ytab[r_] = ra_; ytab[256 + r_] = rb_; } __syncthreads(); } while (0)
            { pg8::Gemm g{A, (const bf16*)(wsl + WS_WO) + (size_t)l * DM * DM, 16384, DM, DM, DM}; pg8::StaticOrder S; S.init(16384, DM, F.G, (int)blockIdx.x);
              { pg8::Unit u0; if (S.next(0, u0)) FILL_YTAB(u0.pm); else __syncthreads(); }
              pg8::EpiResBf E{U, SSQ, (const LAS float*)ytab};
              pg8::gemm_phase<pg8::EpiResBf, pg8::StaticOrder, true, true>(F.lds + RING_OFF, g, S, E); }
#if defined(REP_OUT)
#endif
            { pg8::Gemm g{A, (const bf16*)(wsl + WS_WO) + (size_t)l * DM * DM, MP, DM, 256, DM}; pg8::SplitKOrder S{64, 16, 16, 256, F.G, (int)blockIdx.x};
              FILL_YTAB(64);
              pg8::EpiSlab E{(float*)(wsl + WS_SLAB), 256, (const LAS float*)ytab};
              pg8::gemm_phase<pg8::EpiSlab, pg8::SplitKOrder, true, true>(F.lds + RING_OFF, g, S, E); }
#undef FILL_YTAB
            GRID_BAR(pb + 5);
        }
        if (EN(8) && IN(pb + 6)) {
            WSL_();
            if (l + 1 < DEPTH) { h_rows<1>(F, nullptr, nullptr, U, (const float*)(wsl + WS_SLAB), SSQ, RSTD, nullptr, nullptr); GRID_BAR(pb + 6); }
            else h_rows<2>(F, nullptr, nullptr, U, (const float*)(wsl + WS_SLAB), SSQ, RSTD, args.in[11], args.out);
        }
    }
#undef IN
#undef GRID_BAR
#undef WSL_
#undef U
#undef SSQ
#undef RSTD
#undef SSQY
#undef RATIO
#undef RSB
#undef SSQQ
#undef SSQKV
#undef CQN
#undef CKVN
#undef KR
#undef Zb
#undef QSB
#undef KSB
#undef VSB
#undef QM
#undef KM
#undef VM
#undef A
#undef rope
}

extern "C" void kernel_launch(void* const* d_in, const int* in_sizes, int n_in, void* d_out, int out_size, void* d_ws, size_t ws_size, hipStream_t stream) {
    static int grid = 0;
    if (grid == 0) {
        if (n_in != 12 || in_sizes[0] != BATCH * SEQ * DM || out_size != BATCH * SEQ * DM || ws_size < WS_END) {
            fprintf(stderr, "kernel_launch: shape/workspace mismatch (n_in %d, in0 %d, out %d, ws %zu, need %zu); nothing launched\n", n_in, n_in > 0 ? in_sizes[0] : -1, out_size, ws_size, (size_t)WS_END); grid = -1; return; }
        int dev = 0, cus = 0, per_cu = 0;
        if (hipGetDevice(&dev) != hipSuccess || hipDeviceGetAttribute(&cus, hipDeviceAttributeMultiprocessorCount, dev) != hipSuccess) { grid = -1; return; }
        if (hipFuncSetAttribute((const void*)hymba_fwd, hipFuncAttributeMaxDynamicSharedMemorySize, LDS_BYTES) != hipSuccess) { fprintf(stderr, "kernel_launch: hipFuncSetAttribute failed\n"); grid = -1; return; }
        if (hipOccupancyMaxActiveBlocksPerMultiprocessor(&per_cu, (const void*)hymba_fwd, NWAVES * 64, LDS_BYTES) != hipSuccess || per_cu < 1)
            fprintf(stderr, "kernel_launch: note: occupancy query reports %d workgroups per CU\n", per_cu);
        (void)hipGetLastError();
        grid = cus;
    }
    if (grid < 0) return;
    if (hipMemsetAsync((char*)d_ws + WS_CTL, 0, CTL_ZERO_BYTES, stream) != hipSuccess) return;
    Args a{};
    for (int i = 0; i < 12; ++i) a.in[i] = (const float*)d_in[i];
    a.out = (float*)d_out; a.ws = (unsigned char*)d_ws;
#if MK_MULTI
    for (int ph = 0; ph < NPH; ++ph) { a.ph_lo = ph; a.ph_hi = ph + 1; hipLaunchKernelGGL(hymba_fwd, dim3(grid), dim3(NWAVES * 64), LDS_BYTES, stream, a); }
#else
    a.ph_lo = 0; a.ph_hi = NPH;
    hipLaunchKernelGGL(hymba_fwd, dim3(grid), dim3(NWAVES * 64), LDS_BYTES, stream, a);
#endif
    const hipError_t le = hipPeekAtLastError();
    if (le != hipSuccess) fprintf(stderr, "kernel_launch: launch failed: %s\n", hipGetErrorName(le));
}
```

```cpp
#include <hip/hip_runtime.h>
#include <hip/hip_bf16.h>
#include <cstdio>
#include <cstdint>
#include <cmath>
namespace pg8 {
#define PG8_LAS __attribute__((address_space(3)))
typedef unsigned short bf16_t;
typedef short bf16x8 __attribute__((ext_vector_type(8)));
typedef float f32x4 __attribute__((ext_vector_type(4)));
typedef unsigned u32x4 __attribute__((ext_vector_type(4)));
constexpr int BM = 256, BK = 64, HALF = 128, HTB = HALF * BK * 2  , STAGE_BYTES = 8 * HTB, NXCD = 8, WGM = 8;

__host__ __device__ __forceinline__ int lds_byte(int r, int c) { const int st = (r >> 4) * 2 + (c >> 5), rr = r & 15, cc = c & 31, ob = rr * 64 + cc * 2; return st * 1024 + (ob ^ (((ob >> 9) & 1) << 5)); }
__host__ __device__ __forceinline__ void stage_rc(int b, int& R, int& C) { const int st = b / 1024, sb = b % 1024, swz = sb ^ (((sb >> 9) & 1) << 5); R = (st >> 1) * 16 + swz / 64; C = (st & 1) * 32 + (swz % 64) / 2; }
__host__ __device__ __forceinline__ int perm32(int rho) { const int n = rho >> 4, i = rho & 15; return 8 * (i >> 2) + 4 * n + (i & 3); }

struct Unit { int pm, pn, koff; };
struct Gemm { const bf16_t* A; const bf16_t* Bt; int M, N, K, ld; };

struct StaticOrder {
    int nM, nN, nwg, G, c;
    __host__ __device__ void init(int M, int N, int G_, int c_) { nM = M / BM; nN = N / BM; nwg = nM * nN; G = G_; c = c_; }
    __host__ __device__ __forceinline__ bool next(int i, Unit& u) const {
        const long L = (long)i * G + c; if (L >= nwg) return false;
        int wgid = (int)L; { const int q = nwg / NXCD, r = nwg % NXCD, xcd = wgid % NXCD, off = wgid / NXCD; wgid = (xcd < r ? xcd * (q + 1) : r * (q + 1) + (xcd - r) * q) + off; }
        const int nig = WGM * nN, gid = wgid / nig, fm = gid * WGM, gsz = (nM - fm) < WGM ? (nM - fm) : WGM;
        u.pm = fm + ((wgid % nig) % gsz); u.pn = (wgid % nig) / gsz; u.koff = 0; return true;
    }
    __device__ __forceinline__ void a_ready(const Unit&) const {}
    __device__ __forceinline__ void done(const Unit&) const {}
};
struct InAOrder {
    int G, c;
    __host__ __device__ __forceinline__ bool next(int i, Unit& u) const {
        const int L = i * G + c; if (L >= 512) return false;
        const int x = L & 7, j = L >> 3;
        if (x < 7) { u.pm = 8 * x + (j & 7); u.pn = j >> 3; }
        else if (j < 54) { u.pm = 56 + j % 9; u.pn = j / 9; }
        else { const int jj = j - 54; u.pm = 56 + jj % 5; u.pn = 6 + jj / 5; }
        u.koff = 0; return true;
    }
    __device__ __forceinline__ void a_ready(const Unit&) const {}
    __device__ __forceinline__ void done(const Unit&) const {}
};
struct InBOrder {
    int G, c;
    __host__ __device__ __forceinline__ bool next(int i, Unit& u) const {
        constexpr int nM = 65, nN = 39, nwg = nM * nN;
        const int L = i * G + c; if (L >= nwg + 8) return false;
        u.koff = 0;
        if (L >= nwg) { const int k = L - nwg; u.pm = 61 + (k & 3); u.pn = 6 + (k >> 2); return true; }
        int wgid = L; { constexpr int q = nwg / NXCD, r = nwg % NXCD; const int xcd = wgid % NXCD, off = wgid / NXCD; wgid = (xcd < r ? xcd * (q + 1) : r * (q + 1) + (xcd - r) * q) + off; }
        constexpr int nig = WGM * nN; const int gid = wgid / nig, fm = gid * WGM, gsz = (nM - fm) < WGM ? (nM - fm) : WGM;
        u.pm = fm + ((wgid % nig) % gsz); u.pn = 8 + (wgid % nig) / gsz; return true;
    }
    __device__ __forceinline__ void a_ready(const Unit&) const {}
    __device__ __forceinline__ void done(const Unit&) const {}
};
struct DynOrder {
    __attribute__((address_space(1))) unsigned* ctr; volatile PG8_LAS unsigned* slot; int nM, nN, nwg, nstat, G, c;
    __device__ __forceinline__ bool next(int i, Unit& u) const {
        int L;
        if (i < nstat) L = i * G + c;
        else {
            int t_ = threadIdx.x; asm volatile("" : "+v"(t_));
            if (t_ == 0) { const unsigned v = __hip_atomic_fetch_add(ctr, 1u, __ATOMIC_RELAXED, __HIP_MEMORY_SCOPE_AGENT); slot[i & 1] = (unsigned)(nstat * G) + v; }
            asm volatile("s_waitcnt lgkmcnt(0)" ::: "memory"); __builtin_amdgcn_s_barrier(); asm volatile("" ::: "memory");
            L = __builtin_amdgcn_readfirstlane((int)slot[i & 1]);
        }
        if (L >= nwg) return false;
        const int nig = WGM * nN, gid = L / nig, fm = gid * WGM, gsz = (nM - fm) < WGM ? (nM - fm) : WGM;
        u.pm = fm + ((L % nig) % gsz); u.pn = (L % nig) / gsz; u.koff = 0; return true;
    }
    __device__ __forceinline__ void a_ready(const Unit&) const {}
    __device__ __forceinline__ void done(const Unit&) const {}
};
struct SplitKOrder {
    int pm, nN, nS, kslice, G, c;
    __host__ __device__ __forceinline__ bool next(int i, Unit& u) const { const int L = i * G + c; if (L >= nN * nS) return false; u.pm = pm; u.pn = L % nN; u.koff = (L / nN) * kslice; return true; }
    __device__ __forceinline__ void a_ready(const Unit&) const {}
    __device__ __forceinline__ void done(const Unit&) const {}
};

__device__ __forceinline__ unsigned cvt_pk_bf16(float lo, float hi) { unsigned r; asm volatile("v_cvt_pk_bf16_f32 %0, %1, %2" : "=v"(r) : "v"(lo), "v"(hi)); return r; }
typedef float f32x2 __attribute__((ext_vector_type(2)));

constexpr int SEQL = 4112;
__device__ __forceinline__ void st8_bf16(bf16_t* p, f32x4 v0, f32x4 v1) {
    u32x4 w; w.x = cvt_pk_bf16(v0[0], v0[1]); w.y = cvt_pk_bf16(v0[2], v0[3]); w.z = cvt_pk_bf16(v1[0], v1[1]); w.w = cvt_pk_bf16(v1[2], v1[3]);
    *(u32x4*)p = w;
}
__device__ __forceinline__ float bf_lo(unsigned w) { return __builtin_bit_cast(float, w << 16); }
__device__ __forceinline__ float bf_hi(unsigned w) { return __builtin_bit_cast(float, w & 0xffff0000u); }
__device__ __forceinline__ float st8_bf16_ss(bf16_t* p, f32x4 v0, f32x4 v1) {
    u32x4 w; w.x = cvt_pk_bf16(v0[0], v0[1]); w.y = cvt_pk_bf16(v0[2], v0[3]); w.z = cvt_pk_bf16(v1[0], v1[1]); w.w = cvt_pk_bf16(v1[2], v1[3]);
    *(u32x4*)p = w; float ss = 0.f;
#pragma unroll
    for (int e = 0; e < 4; ++e) { const float x = bf_lo(w[e]), y = bf_hi(w[e]); ss += x * x + y * y; }
    return ss;
}
__device__ __forceinline__ void rope8(const float* tab, f32x4 x1a, f32x4 x1b, f32x4 x2a, f32x4 x2b, bf16_t* o1, bf16_t* o2) {
    const f32x4 c0 = *(const f32x4*)tab, c1 = *(const f32x4*)(tab + 4), s0 = *(const f32x4*)(tab + 32), s1 = *(const f32x4*)(tab + 36);
    st8_bf16(o1, x1a * c0 - x2a * s0, x1b * c1 - x2b * s1);
    st8_bf16(o2, x2a * c0 + x1a * s0, x2b * c1 + x1b * s1);
}
struct EpiIn {
    static constexpr bool PERM = true, AFTER_DRAIN = false, MID = false, PRE = true;
    bf16_t* CQN; bf16_t* CKVN; float* SSQQ; float* SSQKV; bf16_t* KR; bf16_t* Z; bf16_t* QSB; bf16_t* KSB; bf16_t* VSB; const float* rope; const float* rstd;
    __device__ __forceinline__ void pre(float (&p)[4], const Unit& u, int wr, int wc, int fr, int fq) const {
        const int row = u.pm * BM + wr * 64 + fr + (fq >> 1) * HALF + (fq & 1) * 32;
        p[0] = rstd[row]; p[1] = rstd[row + 16];
    }
    __device__ __forceinline__ void epi(const f32x4 (&acc)[2][2][4][2], const Unit& u, int wr, int wc, int fr, int fq, const float (&p)[4]) const {
        const int pn = u.pn, row0 = u.pm * BM + wr * 64 + fr, cin = wc * 32 + 8 * fq;
        float rs[2][4];
#pragma unroll
        for (int ai = 0; ai < 2; ++ai)
#pragma unroll
            for (int m = 0; m < 4; ++m) rs[ai][m] = __shfl(p[m & 1], fr + 16 * (2 * ai + (m >> 1)));
        if (pn < 6) {
            bf16_t* base; float* sq; int ldc, col, nsl, sl;
            if (pn < 4) { base = CQN; ldc = 1024; col = pn * 256; sq = SSQQ; nsl = 16; sl = 4 * pn + wc; } else { base = CKVN; ldc = 512; col = (pn - 4) * 256; sq = SSQKV; nsl = 8; sl = 4 * (pn - 4) + wc; }
#pragma unroll
            for (int ai = 0; ai < 2; ++ai)
#pragma unroll
                for (int m = 0; m < 4; ++m) { const int row = row0 + ai * HALF + m * 16; bf16_t* rowp = base + (size_t)row * ldc + col + cin; float ss = 0.f;
#pragma unroll
                    for (int bj = 0; bj < 2; ++bj) ss += st8_bf16_ss(rowp + bj * HALF, acc[ai][bj][m][0] * rs[ai][m], acc[ai][bj][m][1] * rs[ai][m]);
                    ss += __shfl_xor(ss, 16); ss += __shfl_xor(ss, 32);
                    if (fq == 0) sq[(size_t)row * nsl + sl] = ss; }
        } else if (pn == 6) {
            if (wc == 0) {
#pragma unroll
                for (int ai = 0; ai < 2; ++ai)
#pragma unroll
                    for (int m = 0; m < 4; ++m) { const int row = row0 + ai * HALF + m * 16, pos = row % SEQL;
                        bf16_t* o = KR + (size_t)row * 64 + 8 * fq;
                        rope8(rope + pos * 64 + 8 * fq, acc[ai][0][m][0] * rs[ai][m], acc[ai][0][m][1] * rs[ai][m], acc[ai][1][m][0] * rs[ai][m], acc[ai][1][m][1] * rs[ai][m], o, o + 32); }
            }
        } else {
            bf16_t* base; int ldc, col; float qs = 1.f;
            if (pn < 15) { base = Z; ldc = 4096; col = (pn - 7) * 256; }
            else if (pn < 23) { base = QSB; ldc = 2048; col = (pn - 15) * 256; qs = -0.12751743f; }
            else if (pn < 31) { base = KSB; ldc = 2048; col = (pn - 23) * 256; }
            else if (pn < 39) { base = VSB; ldc = 2048; col = (pn - 31) * 256; }
            else { base = Z; ldc = 4096; col = 2048 + (pn - 39) * 256; }
#pragma unroll
            for (int ai = 0; ai < 2; ++ai)
#pragma unroll
                for (int m = 0; m < 4; ++m) { bf16_t* rowp = base + (size_t)(row0 + ai * HALF + m * 16) * ldc + col + cin;
#pragma unroll
                    for (int bj = 0; bj < 2; ++bj) st8_bf16(rowp + bj * HALF, acc[ai][bj][m][0] * (rs[ai][m] * qs), acc[ai][bj][m][1] * (rs[ai][m] * qs)); }
        }
    }
};
struct EpiUq {
    static constexpr bool PERM = true, AFTER_DRAIN = false, MID = false, PRE = true;
    bf16_t* QM; const float* rope; const float* SSQQ;
    __device__ __forceinline__ void pre(float (&p)[4], const Unit& u, int wr, int wc, int fr, int fq) const {
        const int row = u.pm * BM + wr * 64 + fr + (fq >> 1) * HALF + (fq & 1) * 32;
#pragma unroll
        for (int j = 0; j < 2; ++j) { const f32x4* sp = (const f32x4*)(SSQQ + (size_t)(row + 16 * j) * 16); const f32x4 a = sp[0], b = sp[1], c = sp[2], d = sp[3];
            const float s = ((a[0] + a[1]) + (a[2] + a[3])) + ((b[0] + b[1]) + (b[2] + b[3])) + ((c[0] + c[1]) + (c[2] + c[3])) + ((d[0] + d[1]) + (d[2] + d[3]));
            p[j] = 1.0f / sqrtf(s * (1.0f / 1024.0f) + 1e-6f); }
    }
    __device__ __forceinline__ void epi(const f32x4 (&acc)[2][2][4][2], const Unit& u, int wr, int wc, int fr, int fq, const float (&p)[4]) const {
        const int pn = u.pn, row0 = u.pm * BM + wr * 64 + fr, cin = wc * 32 + 8 * fq;
#define RSQ_(ai, m) (__shfl(p[(m) & 1], fr + 16 * (2 * (ai) + ((m) >> 1))) * 0.10411754f)
        if (pn < 8) {
#pragma unroll
            for (int ai = 0; ai < 2; ++ai)
#pragma unroll
                for (int m = 0; m < 4; ++m) { bf16_t* rowp = QM + (size_t)(row0 + ai * HALF + m * 16) * 3072 + cin; const float r_ = RSQ_(ai, m);
#pragma unroll
                    for (int bj = 0; bj < 2; ++bj) st8_bf16(rowp + (2 * pn + bj) * 192, acc[ai][bj][m][0] * r_, acc[ai][bj][m][1] * r_); }
        } else {
            const int head = 4 * (pn - 8) + wc;
#pragma unroll
            for (int ai = 0; ai < 2; ++ai)
#pragma unroll
                for (int m = 0; m < 4; ++m) { const int row = row0 + ai * HALF + m * 16, pos = row % SEQL; const float r_ = RSQ_(ai, m);
                    bf16_t* o = QM + (size_t)row * 3072 + head * 192 + 128 + 8 * fq;
                    rope8(rope + pos * 64 + 8 * fq, acc[ai][0][m][0] * r_, acc[ai][0][m][1] * r_, acc[ai][1][m][0] * r_, acc[ai][1][m][1] * r_, o, o + 32); }
        }
#undef RSQ_
    }
};
struct EpiUkv {
    static constexpr bool PERM = true, AFTER_DRAIN = false, MID = false, PRE = true;
    bf16_t* KM; bf16_t* VM; const float* SSQKV;
    __device__ __forceinline__ void pre(float (&p)[4], const Unit& u, int wr, int wc, int fr, int fq) const {
        const int row = u.pm * BM + wr * 64 + fr + (fq >> 1) * HALF + (fq & 1) * 32;
#pragma unroll
        for (int j = 0; j < 2; ++j) { const f32x4* sp = (const f32x4*)(SSQKV + (size_t)(row + 16 * j) * 8); const f32x4 a = sp[0], b = sp[1];
            const float s = ((a[0] + a[1]) + (a[2] + a[3])) + ((b[0] + b[1]) + (b[2] + b[3]));
            p[j] = 1.0f / sqrtf(s * (1.0f / 512.0f) + 1e-6f); }
    }
    __device__ __forceinline__ void epi(const f32x4 (&acc)[2][2][4][2], const Unit& u, int wr, int wc, int fr, int fq, const float (&p)[4]) const {
        const int pn = u.pn, row0 = u.pm * BM + wr * 64 + fr, cin = wc * 32 + 8 * fq;

        bf16_t* base = pn < 8 ? KM : VM; const int col = (pn & 7) * 256;
#pragma unroll
        for (int ai = 0; ai < 2; ++ai)
#pragma unroll
            for (int m = 0; m < 4; ++m) { bf16_t* rowp = base + (size_t)(row0 + ai * HALF + m * 16) * 2048 + col + cin;
                const float r_ = __shfl(p[m & 1], fr + 16 * (2 * ai + (m >> 1)));
#pragma unroll
                for (int bj = 0; bj < 2; ++bj) st8_bf16(rowp + bj * HALF, acc[ai][bj][m][0] * r_, acc[ai][bj][m][1] * r_); }
    }
};
struct EpiResBf {
    static constexpr bool PERM = true, AFTER_DRAIN = false, MID = true, PRE = false;
    bf16_t* HB; float* SSQ; const PG8_LAS float* tab;
    __device__ __forceinline__ void mid(f32x4 (&acc)[2][2][4][2], const Unit& u, int wr, int wc, int fr, int fq) const {
        const int row0 = wr * 64 + fr; float f[2][4];
#pragma unroll
        for (int ai = 0; ai < 2; ++ai)
#pragma unroll
            for (int m = 0; m < 4; ++m) f[ai][m] = tab[row0 + ai * HALF + m * 16];
#pragma unroll
        for (int ai = 0; ai < 2; ++ai)
#pragma unroll
            for (int bj = 0; bj < 2; ++bj)
#pragma unroll
                for (int m = 0; m < 4; ++m)
#pragma unroll
                    for (int n = 0; n < 2; ++n) acc[ai][bj][m][n] *= f[ai][m];
    }
    __device__ __forceinline__ void operator()(const f32x4 (&acc)[2][2][4][2], const Unit& u, int wr, int wc, int fr, int fq) const {
        const int row0 = u.pm * BM + wr * 64 + fr, col0 = u.pn * BM + wc * 32 + 8 * fq;
#pragma unroll
        for (int ai = 0; ai < 2; ++ai) {
            u32x4 hv[4][2]; float rsbv[4];
#pragma unroll
            for (int m = 0; m < 4; ++m) { rsbv[m] = tab[256 + wr * 64 + fr + ai * HALF + m * 16];
#pragma unroll
                for (int bj = 0; bj < 2; ++bj) hv[m][bj] = *(const u32x4*)(HB + (size_t)(row0 + ai * HALF + m * 16) * 4096 + col0 + bj * HALF); }
#pragma unroll
            for (int m = 0; m < 4; ++m) { const int row = row0 + ai * HALF + m * 16; float ss = 0.f; const float rsb = rsbv[m];
#pragma unroll
                for (int bj = 0; bj < 2; ++bj) { const u32x4 h = hv[m][bj]; const f32x4 a0 = acc[ai][bj][m][0] * rsb, a1 = acc[ai][bj][m][1] * rsb;
                    u32x4 w; w.x = cvt_pk_bf16(bf_lo(h.x) + a0[0], bf_hi(h.x) + a0[1]); w.y = cvt_pk_bf16(bf_lo(h.y) + a0[2], bf_hi(h.y) + a0[3]);
                    w.z = cvt_pk_bf16(bf_lo(h.z) + a1[0], bf_hi(h.z) + a1[1]); w.w = cvt_pk_bf16(bf_lo(h.w) + a1[2], bf_hi(h.w) + a1[3]);
                    *(u32x4*)(HB + (size_t)row * 4096 + col0 + bj * HALF) = w;
#pragma unroll
                    for (int e = 0; e < 4; ++e) { const float x = bf_lo(w[e]), y = bf_hi(w[e]); ss += x * x + y * y; } }
                ss += __shfl_xor(ss, 16); ss += __shfl_xor(ss, 32);
                if (fq == 0) SSQ[(size_t)row * 64 + 4 * u.pn + wc] = ss; }
            asm volatile("" ::: "memory");
        }
    }
};

struct EpiSlab {
    static constexpr bool PERM = false, AFTER_DRAIN = false, MID = false, PRE = false;
    float* slab; int kslice; const PG8_LAS float* tab;
    __device__ __forceinline__ void operator()(const f32x4 (&acc)[2][2][4][2], const Unit& u, int wr, int wc, int fr, int fq) const {
        if (wr != 0) return;
        float* base = slab + (size_t)(u.koff / kslice) * 64 * 4096 + u.pn * BM + wc * 32 + 4 * fq;
#pragma unroll
        for (int m = 0; m < 4; ++m) { float* rowp = base + (size_t)(fr + m * 16) * 4096; const int row = u.pm * BM + fr + m * 16;
            const float sc = u.koff < 2048 ? tab[fr + m * 16] * tab[256 + fr + m * 16] : tab[256 + fr + m * 16];
#pragma unroll
            for (int bj = 0; bj < 2; ++bj)
#pragma unroll
                for (int n = 0; n < 2; ++n) *(f32x4*)(rowp + bj * HALF + n * 16) = acc[0][bj][m][n] * sc; }
    }
};

template <class Epi, class Sched, bool ALIGN_EPI = false, bool SP2 = false>
__device__ __forceinline__ void gemm_phase(PG8_LAS unsigned char* lds, const Gemm g, const Sched& S, const Epi& E) {
    int tid_ = threadIdx.x; asm volatile("" : "+v"(tid_));
    const int tid = tid_, wid = __builtin_amdgcn_readfirstlane(tid >> 6), lane = tid & 63, wr = wid >> 2, wc = wid & 3, fr = lane & 15, fq = lane >> 4;
    const int K = g.K, nt = K / BK, LD = g.ld ? g.ld : g.K;
    unsigned voffA[2], voffB[2];
#pragma unroll
    for (int i = 0; i < 2; ++i) { int R, C; stage_rc(tid * 16 + i * 8192, R, C); const int Rb = Epi::PERM ? ((R & ~31) + perm32(R & 31)) : R;
        voffA[i] = (unsigned)(R * LD + C) * 2u; voffB[i] = (unsigned)(Rb * LD + C) * 2u; }
    const size_t kstep = (size_t)(BK * 2);
    const size_t hstep = (size_t)HALF * LD * 2;
    const size_t tstep = 2 * hstep;
    const unsigned ldsw = (unsigned)wid * 1024u;
    const int aoff = lds_byte(wr * 64 + fr, fq * 8), boff = lds_byte(wc * 32 + fr, fq * 8);
#define PG8_SA(b, h) (((b) * 2 + (h)) * HTB)
#define PG8_SB(b, h) ((4 + (b) * 2 + (h)) * HTB)
#define PG8_STAGE(bufoff, gbase, voff) do { _Pragma("unroll") for (int _i = 0; _i < 2; ++_i) \
        __builtin_amdgcn_global_load_lds((const unsigned*)((const char*)(gbase) + (voff)[_i]), (PG8_LAS unsigned*)(lds + (bufoff) + ldsw + _i * 8192), 16, 0, 0); } while (0)
#define PG8_LDA(dst, b, h) do { _Pragma("unroll") for (int m = 0; m < 4; ++m) _Pragma("unroll") for (int k = 0; k < 2; ++k) dst[m][k] = *(const PG8_LAS bf16x8*)(lds + PG8_SA(b, h) + aoff + m * 2048 + k * 1024); } while (0)
#define PG8_LDB(dst, b, h) do { _Pragma("unroll") for (int n = 0; n < 2; ++n) _Pragma("unroll") for (int k = 0; k < 2; ++k) dst[n][k] = *(const PG8_LAS bf16x8*)(lds + PG8_SB(b, h) + boff + n * 2048 + k * 1024); } while (0)
#define PG8_MMA(ai, bj, At, Bt) do { __builtin_amdgcn_s_setprio(1); _Pragma("unroll") for (int m = 0; m < 4; ++m) _Pragma("unroll") for (int n = 0; n < 2; ++n) _Pragma("unroll") for (int k = 0; k < 2; ++k) \
        acc[ai][bj][m][n] = __builtin_amdgcn_mfma_f32_16x16x32_bf16(Bt[n][k], At[m][k], acc[ai][bj][m][n], 0, 0, 0); __builtin_amdgcn_s_setprio(0); } while (0)
#define PG8_WAIT_V(n) asm volatile("s_waitcnt vmcnt(" #n ")" ::: "memory")
#define PG8_WAIT_L(n) asm volatile("s_waitcnt lgkmcnt(" #n ")" ::: "memory")
#define PG8_BAR __builtin_amdgcn_s_barrier()
#define PG8_SCHED __builtin_amdgcn_sched_barrier(0)
    Unit cur, nxt; int ui = 0; float epre[4];
    if (!S.next(0, cur)) return;
    f32x4 acc[2][2][4][2];
#pragma unroll
    for (int a = 0; a < 2; ++a)
#pragma unroll
        for (int b = 0; b < 2; ++b)
#pragma unroll
            for (int m = 0; m < 4; ++m)
#pragma unroll
                for (int n = 0; n < 2; ++n) acc[a][b][m][n] = (f32x4){0.f, 0.f, 0.f, 0.f};
    bf16x8 At[4][2], B0[2][2], B1[2][2];
    const char* cA = (const char*)g.A + (size_t)cur.pm * tstep + (size_t)cur.koff * 2; const char* cB = (const char*)g.Bt + (size_t)cur.pn * tstep + (size_t)cur.koff * 2;
    S.a_ready(cur);
    if constexpr (SP2) {
        PG8_STAGE(PG8_SB(0, 0), cB, voffB); PG8_STAGE(PG8_SB(0, 1), cB + hstep, voffB); PG8_STAGE(PG8_SA(0, 0), cA, voffA); PG8_STAGE(PG8_SA(0, 1), cA + hstep, voffA);
        if (wr == 1) PG8_BAR;
        PG8_WAIT_V(2); PG8_BAR;
        PG8_STAGE(PG8_SB(1, 0), cB + kstep, voffB); PG8_STAGE(PG8_SA(1, 0), cA + kstep, voffA); PG8_STAGE(PG8_SB(1, 1), cB + hstep + kstep, voffB);
        PG8_WAIT_V(6); PG8_BAR;
    } else {
        PG8_STAGE(PG8_SB(0, 0), cB, voffB); PG8_STAGE(PG8_SA(0, 0), cA, voffA); PG8_STAGE(PG8_SB(0, 1), cB + hstep, voffB); PG8_STAGE(PG8_SA(0, 1), cA + hstep, voffA);
        if (wr == 1) PG8_BAR;
        PG8_WAIT_V(4); PG8_BAR;
        PG8_STAGE(PG8_SB(1, 0), cB + kstep, voffB); PG8_STAGE(PG8_SA(1, 0), cA + kstep, voffA); PG8_STAGE(PG8_SB(1, 1), cB + hstep + kstep, voffB);
        PG8_WAIT_V(6); PG8_BAR;
    }
    for (;;) {
        const bool has_next = S.next(ui + 1, nxt);
        const char* nA = has_next ? (const char*)g.A + (size_t)nxt.pm * tstep + (size_t)nxt.koff * 2 : cA; const char* nB = has_next ? (const char*)g.Bt + (size_t)nxt.pn * tstep + (size_t)nxt.koff * 2 : cB;
        for (int t = 0; t < nt; t += 2) {
            if constexpr (Epi::PRE) { if (t == (nt >> 1) - 2) E.pre(epre, cur, wr, wc, fr, fq); }
            if constexpr (Epi::MID) { if (t == (nt >> 1)) E.mid(acc, cur, wr, wc, fr, fq); }
            const bool last = (t == nt - 2);
            const char* a1 = cA + (size_t)(t + 1) * kstep;
            const char* a2 = last ? nA : cA + (size_t)(t + 2) * kstep; const char* b2 = last ? nB : cB + (size_t)(t + 2) * kstep;
            const char* a3 = a2 + kstep; const char* b3 = b2 + kstep;
            if (last && has_next) S.a_ready(nxt);
            if constexpr (SP2) {
            PG8_LDB(B0, 0, 0); PG8_LDB(B1, 0, 1); PG8_SCHED; PG8_LDA(At, 0, 0); PG8_STAGE(PG8_SA(1, 1), a1 + hstep, voffA);
            PG8_WAIT_V(8); PG8_WAIT_L(0); PG8_BAR; PG8_MMA(0, 0, At, B0); PG8_MMA(0, 1, At, B1); PG8_BAR; PG8_SCHED;
            PG8_LDA(At, 0, 1); PG8_STAGE(PG8_SB(0, 0), b2, voffB); PG8_STAGE(PG8_SB(0, 1), b2 + hstep, voffB); PG8_STAGE(PG8_SA(0, 0), a2, voffA);
            PG8_WAIT_V(8); PG8_WAIT_L(0); PG8_BAR; PG8_MMA(1, 0, At, B0); PG8_MMA(1, 1, At, B1); PG8_BAR; PG8_SCHED;
            PG8_LDB(B0, 1, 0); PG8_LDB(B1, 1, 1); PG8_SCHED; PG8_LDA(At, 1, 0); PG8_STAGE(PG8_SA(0, 1), a2 + hstep, voffA);
            PG8_WAIT_V(8); PG8_WAIT_L(0); PG8_BAR; PG8_MMA(0, 0, At, B0); PG8_MMA(0, 1, At, B1); PG8_BAR; PG8_SCHED;
            PG8_LDA(At, 1, 1); PG8_STAGE(PG8_SB(1, 0), b3, voffB); PG8_STAGE(PG8_SB(1, 1), b3 + hstep, voffB); PG8_STAGE(PG8_SA(1, 0), a3, voffA);
            PG8_WAIT_V(8); PG8_WAIT_L(0); PG8_BAR; PG8_MMA(1, 0, At, B0); PG8_MMA(1, 1, At, B1); PG8_BAR; PG8_SCHED;
            } else {
            PG8_LDB(B0, 0, 0); PG8_SCHED; PG8_LDA(At, 0, 0); PG8_STAGE(PG8_SA(1, 1), a1 + hstep, voffA);
            PG8_WAIT_L(8); PG8_BAR; PG8_WAIT_L(0); PG8_MMA(0, 0, At, B0); PG8_BAR; PG8_SCHED;
            PG8_LDB(B1, 0, 1); PG8_STAGE(PG8_SB(0, 0), b2, voffB);
            PG8_BAR; PG8_WAIT_L(0); PG8_MMA(0, 1, At, B1); PG8_BAR;
            PG8_LDA(At, 0, 1); PG8_STAGE(PG8_SA(0, 0), a2, voffA);
            PG8_BAR; PG8_WAIT_L(0); PG8_MMA(1, 0, At, B0); PG8_BAR; PG8_SCHED;
            PG8_STAGE(PG8_SB(0, 1), b2 + hstep, voffB);
            PG8_WAIT_V(6); PG8_BAR; PG8_MMA(1, 1, At, B1); PG8_BAR;
            PG8_LDB(B0, 1, 0); PG8_SCHED; PG8_LDA(At, 1, 0); PG8_STAGE(PG8_SA(0, 1), a2 + hstep, voffA);
            PG8_WAIT_L(8); PG8_BAR; PG8_WAIT_L(0); PG8_MMA(0, 0, At, B0); PG8_BAR; PG8_SCHED;
            PG8_LDB(B1, 1, 1); PG8_STAGE(PG8_SB(1, 0), b3, voffB);
            PG8_BAR; PG8_WAIT_L(0); PG8_MMA(0, 1, At, B1); PG8_BAR;
            PG8_LDA(At, 1, 1); PG8_STAGE(PG8_SA(1, 0), a3, voffA);
            PG8_BAR; PG8_WAIT_L(0); PG8_MMA(1, 0, At, B0); PG8_BAR; PG8_SCHED;
            PG8_STAGE(PG8_SB(1, 1), b3 + hstep, voffB);
            PG8_WAIT_V(6); PG8_BAR; PG8_MMA(1, 1, At, B1); PG8_BAR;
            }
        }
        if constexpr (ALIGN_EPI) { if (wr == 0) PG8_BAR; }
        if constexpr (!Epi::AFTER_DRAIN) { if constexpr (Epi::PRE) E.epi(acc, cur, wr, wc, fr, fq, epre); else E(acc, cur, wr, wc, fr, fq); S.done(cur); }
        if (!has_next) break;
#pragma unroll
        for (int a = 0; a < 2; ++a)
#pragma unroll
            for (int b = 0; b < 2; ++b)
#pragma unroll
                for (int m = 0; m < 4; ++m)
#pragma unroll
                    for (int n = 0; n < 2; ++n) acc[a][b][m][n] = (f32x4){0.f, 0.f, 0.f, 0.f};
        cur = nxt; cA = nA; cB = nB; ++ui;
        if constexpr (ALIGN_EPI) { if (wr == 1) PG8_BAR; }
    }
    PG8_WAIT_V(0);
    if constexpr (!ALIGN_EPI) { if (wr == 0) PG8_BAR; }
    PG8_BAR;
    if constexpr (Epi::AFTER_DRAIN) { E.fused(acc, cur, wr, wc, fr, fq, lds, wid, lane); S.done(cur); }
#undef PG8_SA
#undef PG8_SB
#undef PG8_STAGE
#undef PG8_LDA
#undef PG8_LDB
#undef PG8_MMA
#undef PG8_WAIT_V
#undef PG8_WAIT_L
#undef PG8_BAR
#undef PG8_SCHED
}
}

namespace att {
typedef unsigned short bf16_t;
typedef short bf16x8 __attribute__((ext_vector_type(8)));
typedef short s16x4 __attribute__((ext_vector_type(4)));
typedef float f32x16 __attribute__((ext_vector_type(16)));
typedef float f32x4 __attribute__((ext_vector_type(4)));
typedef unsigned u32x4 __attribute__((ext_vector_type(4)));
constexpr int NW = 8, QBLK = 32, KVBLK = 64, QB = NW * QBLK;
constexpr int SHM_V = KVBLK * 128 * 2, SHM_KN = KVBLK * 128 * 2, SHM_KR = KVBLK * 64 * 2;
constexpr int OFF_V = 0, OFF_KN = 2 * SHM_V, OFF_KR = OFF_KN + 2 * SHM_KN, OFF_WS = OFF_KR + 2 * SHM_KR, OFF_QR = OFF_WS + NW * 64 * 4, ATT_LDS = OFF_QR + NW * 4096;
constexpr int kn_off(int b) { return b == 2 ? OFF_QR : OFF_KN + b * SHM_KN; }
constexpr int v_off(int b) { return b == 2 ? OFF_KR : OFF_V + b * SHM_V; }
constexpr int LDQM = 3072, LDK = 2048, LDKR = 64, LDV = 2048, LDO = 4096, LDQS = 2048;
constexpr float LOG2E = 1.4426950408889634f;
constexpr float MLA_SCALE = 0.07216878364870323f;
constexpr float SB_SCALE = 0.08838834764831845f;
constexpr unsigned WBIG = 0x40000000u;

#define KSWZ(row, colB) ((row) * 256 + ((colB) ^ (((row) & 15) << 4)))
#define KRSWZ(row, colB) ((row) * 128 + ((colB) ^ ((((row) >> 1) & 7) << 4)))
#define SBAR() __builtin_amdgcn_sched_barrier(0)
#define ATT_LAS __attribute__((address_space(3)))
__device__ __forceinline__ int v_st(int k, int c) { const int kk = (k & ~0xC) | ((k & 4) << 1) | ((k & 8) >> 1); return ((kk >> 3) * 4 + (c >> 5)) * 512 + ((kk & 7) * 32 + (c & 31)) * 2; }
__device__ __forceinline__ int v_rd_base(int lane) { return ((lane & 3) << 3) | (((lane >> 2) & 3) << 6) | (((lane >> 4) & 1) << 5) | (((lane >> 5) & 1) << 8); }
constexpr int v_rd_off(int d0, int ks, int half) { return d0 * 512 + ks * 4096 + half * 2048; }
__device__ __forceinline__ int crow(int r, int hi) { return (r & 3) + 8 * (r >> 2) + 4 * hi; }
__device__ __forceinline__ unsigned cvtpk(float lo, float hi) { unsigned r; asm volatile("v_cvt_pk_bf16_f32 %0, %1, %2" : "=v"(r) : "v"(lo), "v"(hi)); return r; }
__device__ __forceinline__ void mask_tile(f32x16& p0, f32x16& p1, int dq) {
    const float NEG = -__builtin_inff();
#pragma unroll
    for (int r = 0; r < 16; ++r) {
        const int c = (r & 3) + 8 * (r >> 2);
        if ((unsigned)(dq - c) >= WBIG) p0[r] = NEG;
        if ((unsigned)(dq - c - 32) >= WBIG) p1[r] = NEG;
    }
}
constexpr float THR = 8.f;
__device__ __forceinline__ void partialSM(f32x16& p0, f32x16& p1, float& m_reg, float& mn, float& alpha) {
    constexpr float SCALE = MLA_SCALE;
    float pmax = p0[0];
#pragma unroll
    for (int r = 1; r < 16; ++r) pmax = fmaxf(pmax, p0[r]);
#pragma unroll
    for (int r = 0; r < 16; ++r) pmax = fmaxf(pmax, p1[r]);
    { auto rr = __builtin_amdgcn_permlane32_swap(__float_as_uint(pmax), __float_as_uint(pmax), false, false);
      pmax = fmaxf(__uint_as_float(rr[0]), __uint_as_float(rr[1])); }
    constexpr float C2 = LOG2E * SCALE;
    if (__builtin_expect(__all((pmax - m_reg) * SCALE <= THR), 1)) { mn = m_reg; alpha = 1.f; }
    else { mn = fmaxf(m_reg, pmax); alpha = __builtin_amdgcn_exp2f((m_reg - mn) * C2); m_reg = mn; }
    const float mnL = -mn * C2;
#pragma unroll
    for (int r = 0; r < 16; ++r) p0[r] = fmaf(p0[r], C2, mnL);
#pragma unroll
    for (int r = 0; r < 16; ++r) p1[r] = fmaf(p1[r], C2, mnL);
#pragma unroll
    for (int r = 0; r < 16; ++r) p0[r] = __builtin_amdgcn_exp2f(p0[r]);
}
#define PK4(P, B_, OUT) do { unsigned a0 = cvtpk(P[B_+0], P[B_+1]), a1 = cvtpk(P[B_+2], P[B_+3]);                          \
        unsigned b0 = cvtpk(P[B_+4], P[B_+5]), b1 = cvtpk(P[B_+6], P[B_+7]);                                             \
        auto r0 = __builtin_amdgcn_permlane32_swap(a0, b0, false, false); auto r1 = __builtin_amdgcn_permlane32_swap(a1, b1, false, false); \
        u32x4 w = {r0[0], r1[0], r0[1], r1[1]}; OUT = *reinterpret_cast<bf16x8*>(&w); } while (0)
__device__ __forceinline__ void finishSM(f32x16& p0, f32x16& p1, float alpha, float& l_reg, bf16x8& pa0, bf16x8& pa1, bf16x8& pa2, bf16x8& pa3) {
#pragma unroll
    for (int r = 0; r < 16; ++r) p1[r] = __builtin_amdgcn_exp2f(p1[r]);
    float ps = 0;
#pragma unroll
    for (int r = 0; r < 16; ++r) ps += p0[r];
#pragma unroll
    for (int r = 0; r < 16; ++r) ps += p1[r];
    { auto rr = __builtin_amdgcn_permlane32_swap(__float_as_uint(ps), __float_as_uint(ps), false, false);
      ps = __uint_as_float(rr[0]) + __uint_as_float(rr[1]); }
    l_reg = l_reg * alpha + ps;
    PK4(p0, 0, pa0); PK4(p0, 8, pa1); PK4(p1, 0, pa2); PK4(p1, 8, pa3);
}
constexpr float THR2 = 8.f * LOG2E;
__device__ __forceinline__ float max3f(float a, float b, float c) { return __builtin_fmaxf(__builtin_fmaxf(a, b), c); }
__device__ __forceinline__ void softmax_c(f32x16& p0, f32x16& p1, bool first, float& m_ref, f32x16& negm, float& l_reg, float& alpha, bf16x8& pa0, bf16x8& pa1, bf16x8& pa2, bf16x8& pa3) {
    float a = max3f(p0[0], p0[1], p1[0]), b = max3f(p0[2], p0[3], p1[1]); a = max3f(a, p1[2], p1[3]);
#pragma unroll
    for (int r = 4; r < 16; r += 4) { a = max3f(a, p0[r], p0[r + 1]); b = max3f(b, p0[r + 2], p0[r + 3]); a = max3f(a, p1[r], p1[r + 1]); b = max3f(b, p1[r + 2], p1[r + 3]); }
    float pmax = __builtin_fmaxf(a, b);
    { auto rr = __builtin_amdgcn_permlane32_swap(__float_as_uint(pmax), __float_as_uint(pmax), false, false);
      pmax = __builtin_fmaxf(__uint_as_float(rr[0]), __uint_as_float(rr[1])); }
    alpha = 1.f;
    if (__builtin_expect(first || __any(pmax > THR2), 0)) {
        const float dl = first ? pmax : __builtin_fmaxf(pmax, 0.f); m_ref += dl;
#pragma unroll
        for (int r = 0; r < 16; ++r) { p0[r] -= dl; p1[r] -= dl; }
#pragma unroll
        for (int r = 0; r < 16; ++r) negm[r] = -m_ref;
        alpha = first ? 1.f : __builtin_amdgcn_exp2f(-dl);
    }
#pragma unroll
    for (int r = 0; r < 16; ++r) { p0[r] = __builtin_amdgcn_exp2f(p0[r]); p1[r] = __builtin_amdgcn_exp2f(p1[r]); }
    float ps = 0;
#pragma unroll
    for (int r = 0; r < 16; ++r) ps += p0[r];
#pragma unroll
    for (int r = 0; r < 16; ++r) ps += p1[r];
    { auto rr = __builtin_amdgcn_permlane32_swap(__float_as_uint(ps), __float_as_uint(ps), false, false);
      ps = __uint_as_float(rr[0]) + __uint_as_float(rr[1]); }
    l_reg = l_reg * alpha + ps;
    PK4(p0, 0, pa0); PK4(p0, 8, pa1); PK4(p1, 0, pa2); PK4(p1, 8, pa3);
}
template <int KB, bool ROPE, int NREG = 8, bool CINIT = false>
__device__ __forceinline__ void qkt(f32x16& p0, f32x16& p1, const char* lds, int r32, int hi, const bf16x8* qr, const char* qpark = nullptr, const f32x16* cinit = nullptr) {
    if constexpr (!CINIT) { p0 = f32x16{}; p1 = f32x16{}; }
    int ysw = (hi * 16) ^ ((r32 & 15) << 4); asm volatile("" : "+v"(ysw));
    const char* krow = lds + kn_off(KB) + r32 * 256;
#pragma unroll
    for (int d0 = 0; d0 < 8; ++d0) { const char* a = krow + ((d0 * 32) ^ ysw);
        bf16x8 b0 = *reinterpret_cast<const bf16x8*>(a);
        bf16x8 b1 = *reinterpret_cast<const bf16x8*>(a + 32 * 256);
        bf16x8 qf; if (d0 < NREG) qf = qr[d0]; else qf = *reinterpret_cast<const bf16x8*>(qpark + (d0 - NREG) * 1024);
        if (CINIT && d0 == 0) { p0 = __builtin_amdgcn_mfma_f32_32x32x16_bf16(b0, qf, *cinit, 0, 0, 0); p1 = __builtin_amdgcn_mfma_f32_32x32x16_bf16(b1, qf, *cinit, 0, 0, 0); }
        else { p0 = __builtin_amdgcn_mfma_f32_32x32x16_bf16(b0, qf, p0, 0, 0, 0);
               p1 = __builtin_amdgcn_mfma_f32_32x32x16_bf16(b1, qf, p1, 0, 0, 0); } }
    if constexpr (ROPE) {
#pragma unroll
        for (int d0 = 0; d0 < 4; ++d0) { const char* a = lds + OFF_KR + KB * SHM_KR + KRSWZ(r32, (d0 * 16 + hi * 8) * 2);
            bf16x8 b0 = *reinterpret_cast<const bf16x8*>(a);
            bf16x8 b1 = *reinterpret_cast<const bf16x8*>(a + 32 * 128);
            bf16x8 qf; if (NREG >= 12) qf = qr[8 + d0]; else qf = *reinterpret_cast<const bf16x8*>(qpark + d0 * 1024);
            p0 = __builtin_amdgcn_mfma_f32_32x32x16_bf16(b0, qf, p0, 0, 0, 0);
            p1 = __builtin_amdgcn_mfma_f32_32x32x16_bf16(b1, qf, p1, 0, 0, 0); }
    }
}
template <int VB>
__device__ __forceinline__ void pv_tile(f32x16* o, int vb0, bf16x8 pa0, bf16x8 pa1, bf16x8 pa2, bf16x8 pa3) {
    const int vbx = VB == 2 ? vb0 + v_off(2) : vb0;
#define TRRD(dst, off) asm volatile("ds_read_b64_tr_b16 %0, %1 offset:%2" : "=&v"(dst) : "v"(vbx), "i"(off) : "memory")
#define PV_D0(d0) do { s16x4 l0, l1, l2, l3, h0, h1, h2, h3; constexpr int b_ = (VB == 2 ? 0 : v_off(VB)) + v_rd_off(d0, 0, 0); \
        TRRD(l0, b_); TRRD(h0, b_ + 2048); TRRD(l1, b_ + 4096); TRRD(h1, b_ + 6144); TRRD(l2, b_ + 8192); TRRD(h2, b_ + 10240); TRRD(l3, b_ + 12288); TRRD(h3, b_ + 14336); \
        asm volatile("s_waitcnt lgkmcnt(0)" ::: "memory"); SBAR();   \
        o[d0] = __builtin_amdgcn_mfma_f32_32x32x16_bf16(pa0, (bf16x8){l0[0], l0[1], l0[2], l0[3], h0[0], h0[1], h0[2], h0[3]}, o[d0], 0, 0, 0);   \
        o[d0] = __builtin_amdgcn_mfma_f32_32x32x16_bf16(pa1, (bf16x8){l1[0], l1[1], l1[2], l1[3], h1[0], h1[1], h1[2], h1[3]}, o[d0], 0, 0, 0);   \
        o[d0] = __builtin_amdgcn_mfma_f32_32x32x16_bf16(pa2, (bf16x8){l2[0], l2[1], l2[2], l2[3], h2[0], h2[1], h2[2], h2[3]}, o[d0], 0, 0, 0);   \
        o[d0] = __builtin_amdgcn_mfma_f32_32x32x16_bf16(pa3, (bf16x8){l3[0], l3[1], l3[2], l3[3], h3[0], h3[1], h3[2], h3[3]}, o[d0], 0, 0, 0); } while (0)
    PV_D0(0); PV_D0(1); PV_D0(2); PV_D0(3);
#undef PV_D0
#undef TRRD
}
#define VMW() asm volatile("s_waitcnt vmcnt(0)" ::: "memory")
__device__ __forceinline__ float silu_f(float z) { return z * __builtin_amdgcn_rcpf(1.0f + __builtin_amdgcn_exp2f(-LOG2E * z)); }
template <int CTRL> __device__ __forceinline__ float dpp_f(float v) { return __builtin_bit_cast(float, __builtin_amdgcn_update_dpp(0, __builtin_bit_cast(int, v), CTRL, 0xf, 0xf, true)); }
template <bool ALLOK>
__device__ __forceinline__ void store_o_t(const f32x16* o, const float* sc, bf16_t* Aw, const u32x4* zz, float* ssq, int qlo, int r32, int hi, char* stg) {
    const int lane = hi * 32 + r32, rr = lane >> 4, ch = lane & 15; const bool odd = (r32 & 1) != 0;
    float ss[16];
    char* sw = stg + ((odd ? 32 + r32 - 1 : r32) * 2);
#pragma unroll
    for (int r = 0; r < 16; ++r) { const int orow = crow(r, hi); float v[4]; ss[r] = 0.f;
#pragma unroll
        for (int d0 = 0; d0 < 4; ++d0) { v[d0] = o[d0][r] * sc[r]; ss[r] += v[d0] * v[d0]; }
#pragma unroll
        for (int dp = 0; dp < 4; dp += 2) { const float x0 = dpp_f<0xB1>(v[dp]), x1 = dpp_f<0xB1>(v[dp + 1]);
            *(unsigned*)(sw + orow * 256 + dp * 64) = odd ? cvtpk(x1, v[dp + 1]) : cvtpk(v[dp], x0); } }
#pragma unroll
    for (int r = 0; r < 16; ++r) ss[r] += dpp_f<0x128>(ss[r]);
#pragma unroll
    for (int r = 0; r < 16; ++r) ss[r] += dpp_f<0x124>(ss[r]);
#pragma unroll
    for (int r = 0; r < 16; ++r) ss[r] += dpp_f<0x122>(ss[r]);
#pragma unroll
    for (int r = 0; r < 16; ++r) ss[r] += dpp_f<0x121>(ss[r]);
    float sx[16];
#pragma unroll
    for (int r = 0; r < 16; ++r) sx[r] = __builtin_bit_cast(float, __builtin_amdgcn_ds_swizzle(__builtin_bit_cast(int, ss[r]), 0x401F));
    asm volatile("s_waitcnt lgkmcnt(0)" ::: "memory");
    if (r32 == 0) {
#pragma unroll
        for (int r = 0; r < 16; ++r) { const int orow = crow(r, hi); if (ALLOK || qlo + orow >= 0) ssq[(long)orow * 32] = ss[r] + sx[r]; } }
#pragma unroll
    for (int i = 0; i < 8; ++i) { const int row = 4 * i + rr; const u32x4 y = *(const u32x4*)(stg + row * 256 + ch * 16); const u32x4 z = zz[i]; u32x4 w;
#pragma unroll
        for (int e = 0; e < 4; ++e) { const float y0 = __builtin_bit_cast(float, y[e] << 16), y1 = __builtin_bit_cast(float, y[e] & 0xffff0000u);
            const float z0 = __builtin_bit_cast(float, z[e] << 16), z1 = __builtin_bit_cast(float, z[e] & 0xffff0000u); w[e] = cvtpk(y0 * silu_f(z0), y1 * silu_f(z1)); }
        if (ALLOK || qlo + row >= 0) *(u32x4*)(Aw + (long)row * LDO + ch * 8) = w; }
}
__device__ __forceinline__ void load_z(u32x4* zz, const bf16_t* Zw, int qlo, int lane) {
    const int rr = lane >> 4, ch = lane & 15;
#pragma unroll
    for (int i = 0; i < 8; ++i) zz[i] = (qlo + 4 * i + rr >= 0) ? *(const u32x4*)(Zw + (long)(4 * i + rr) * LDO + ch * 8) : (u32x4){0u, 0u, 0u, 0u};
}
__device__ __forceinline__ void store_o(const f32x16* o, const float* sc, bf16_t* Aw  , const u32x4* zz, float* ssq  , int qlo, int r32, int hi, char* stg) {
    if (qlo >= 0) store_o_t<true>(o, sc, Aw, zz, ssq, qlo, r32, hi, stg); else store_o_t<false>(o, sc, Aw, zz, ssq, qlo, r32, hi, stg);
}

__device__ __forceinline__ void mla_block(const bf16_t* Qh, const bf16_t* KNh, const bf16_t* KRh, const bf16_t* Vh, bf16_t* Oh, const bf16_t* Zh, float* ssq, int qb, char* lds) {
    int tid_ = threadIdx.x; asm volatile("" : "+v"(tid_));
    const int tid = tid_, wid = __builtin_amdgcn_readfirstlane(tid >> 6), lane = tid & 63, r32 = lane & 31, hi = lane >> 5;
    const int P0 = 256 * qb - 240, NT = 4 * qb + 1;
    const int qlo = P0 + wid * QBLK, qm = qlo + r32 - 4 * hi;
    float* ws = (float*)(lds + OFF_WS) + wid * 64; float* li_l = ws; float* al_l = ws + 32;
    float m_ref = 0.f, l_reg = 0; f32x16 o[4] = {}; f32x16 negm = {};
    const int vb0 = (int)(uintptr_t)lds + v_rd_base(lane);
    int gk0, gk1, gv0, gv1, gkr;
    { const int o0 = 1024 * (2 * wid) + 16 * lane, o1 = o0 + 1024;
      { const int row = o0 >> 8, cb = (o0 & 255) ^ ((row & 15) << 4); gk0 = row * LDK + (cb >> 1); }
      { const int row = o1 >> 8, cb = (o1 & 255) ^ ((row & 15) << 4); gk1 = row * LDK + (cb >> 1); }
      { const int sub = o0 >> 9, w_ = o0 & 511, kk = (sub >> 2) * 8 + (w_ >> 6), c = (sub & 3) * 32 + ((w_ & 63) >> 1), k = (kk & ~0xC) | ((kk & 4) << 1) | ((kk & 8) >> 1); gv0 = k * LDV + c; }
      { const int sub = o1 >> 9, w_ = o1 & 511, kk = (sub >> 2) * 8 + (w_ >> 6), c = (sub & 3) * 32 + ((w_ & 63) >> 1), k = (kk & ~0xC) | ((kk & 4) << 1) | ((kk & 8) >> 1); gv1 = k * LDV + c; }
      { const int o2 = 1024 * wid + 16 * lane, row = o2 >> 7, cb = (o2 & 127) ^ (((row >> 1) & 7) << 4); gkr = row * LDKR + (cb >> 1); } }
    ATT_LAS char* ldsl = (ATT_LAS char*)lds;
#define DMA16(gp, lo) __builtin_amdgcn_global_load_lds((const unsigned*)(gp), (ATT_LAS unsigned*)(ldsl + (lo)), 16, 0, 0)
#define SDMA(t, bf) do { const long k0_ = (long)(t) * KVBLK; \
        DMA16(Vh + k0_ * LDV + gv0, OFF_V + (bf) * SHM_V + 2048 * wid); DMA16(Vh + k0_ * LDV + gv1, OFF_V + (bf) * SHM_V + 2048 * wid + 1024); \
        DMA16(KNh + k0_ * LDK + gk0, OFF_KN + (bf) * SHM_KN + 2048 * wid); DMA16(KNh + k0_ * LDK + gk1, OFF_KN + (bf) * SHM_KN + 2048 * wid + 1024); \
        DMA16(KRh + k0_ * LDKR + gkr, OFF_KR + (bf) * SHM_KR + 1024 * wid); } while (0)
#define RESC(a) do { if (__any((a) < 1.f)) { if (hi == 0) al_l[r32] = (a); asm volatile("s_waitcnt lgkmcnt(0)" ::: "memory");              \
                     for (int d_ = 0; d_ < 4; ++d_) for (int r = 0; r < 16; ++r) o[d_][r] *= al_l[crow(r, hi)]; } } while (0)
#define MASKT(P0_, P1_, t) do { const int kb_ = (t) * KVBLK; if (kb_ + KVBLK - 1 > qlo) mask_tile(P0_, P1_, qm - kb_); } while (0)
    SDMA(0, 0);
    bf16x8 qr[12];
    { int qrow = qlo + r32; qrow = qrow < 0 ? 0 : qrow; const bf16_t* qp = Qh + (long)qrow * LDQM + hi * 8;
#pragma unroll
      for (int d0 = 0; d0 < 12; ++d0) qr[d0] = *(const bf16x8*)(qp + d0 * 16); }
    VMW();
    __syncthreads();
    f32x16 p0, p1; float al; bf16x8 pa0, pa1, pa2, pa3;
#define MLA_STEP(t, BUF) do { const int t_ = (t);                                                         \
        if (t_ + 1 < NT) { SDMA(t_ + 1, (BUF) ^ 1); SBAR(); }                                              \
        if (t_ * KVBLK <= qlo + QBLK - 1) {                                                                \
            qkt<BUF, true, 12, true>(p0, p1, lds, r32, hi, qr, nullptr, &negm);                            \
            MASKT(p0, p1, t_); softmax_c(p0, p1, t_ == 0, m_ref, negm, l_reg, al, pa0, pa1, pa2, pa3); RESC(al); SBAR();   \
            pv_tile<BUF>(o, vb0, pa0, pa1, pa2, pa3); }                                                   \
        VMW();                                                                                             \
        __syncthreads(); } while (0)
    for (int t = 0; t + 1 < NT; t += 2) { MLA_STEP(t, 0); MLA_STEP(t + 1, 1); }
    MLA_STEP(NT - 1, 0);
#undef MLA_STEP
    u32x4 zz[8]; load_z(zz, Zh + (long)qlo * LDO, qlo, lane);
    if (hi == 0) li_l[r32] = l_reg; asm volatile("s_waitcnt lgkmcnt(0)" ::: "memory");
    float rli[16];
#pragma unroll
    for (int r = 0; r < 16; ++r) rli[r] = __builtin_amdgcn_rcpf(li_l[crow(r, hi)]);
    store_o(o, rli, Oh + (long)qlo * LDO, zz, ssq + (long)qlo * 32, qlo, r32, hi, lds + wid * 8192);
    __syncthreads();
#undef MASKT
#undef RESC
#undef SDMA
#undef DMA16
}

__device__ __forceinline__ void sb_elem(f32x16& p0, f32x16& p1, float& carry, bool need_mask, int dq, bool hi0, bf16x8& pa0, bf16x8& pa1, bf16x8& pa2, bf16x8& pa3) {
    f32x16 m0, m1;
    { const f32x16 y0 = p0, y1 = p1; f32x16 e0, e1;
#pragma unroll
      for (int r = 0; r < 16; ++r) { e0[r] = __builtin_amdgcn_exp2f(__builtin_amdgcn_fmed3f(y0[r], 126.f, -__builtin_inff())); e1[r] = __builtin_amdgcn_exp2f(__builtin_amdgcn_fmed3f(y1[r], 126.f, -__builtin_inff())); }
      const f32x16 t0 = e0 + 1.0f, t1 = e1 + 1.0f;
#pragma unroll
      for (int r = 0; r < 16; ++r) { p0[r] = __builtin_amdgcn_rcpf(t0[r]); p1[r] = __builtin_amdgcn_rcpf(t1[r]); }
      m0 = e0 * p0; m1 = e1 * p1; }
    if (need_mask) {
#pragma unroll
        for (int r = 0; r < 16; ++r) { const int c = (r & 3) + 8 * (r >> 2);
            if ((unsigned)(dq - c) >= WBIG) { p0[r] = 0.f; m0[r] = 1.f; }
            if ((unsigned)(dq - c - 32) >= WBIG) { p1[r] = 0.f; m1[r] = 1.f; } }
    }
    float T[8], GH[8];
#pragma unroll
    for (int m = 0; m < 8; ++m) { const float g = m < 4 ? (m0[4 * m] * m0[4 * m + 1]) * (m0[4 * m + 2] * m0[4 * m + 3]) : (m1[4 * (m - 4)] * m1[4 * (m - 4) + 1]) * (m1[4 * (m - 4) + 2] * m1[4 * (m - 4) + 3]);
        auto rr = __builtin_amdgcn_permlane32_swap(__float_as_uint(g), __float_as_uint(g), false, false);
        T[m] = __uint_as_float(rr[0]) * __uint_as_float(rr[1]); GH[m] = __uint_as_float(rr[1]); }
    float SS = carry;
#pragma unroll
    for (int m = 7; m >= 0; --m) {
        const float t3 = SS * (hi0 ? GH[m] : 1.0f);
        if (m < 4) { const float t2 = t3 * m0[4 * m + 3], t1 = t2 * m0[4 * m + 2], t0 = t1 * m0[4 * m + 1];
            p0[4 * m + 3] *= t3; p0[4 * m + 2] *= t2; p0[4 * m + 1] *= t1; p0[4 * m] *= t0; }
        else { const int q = 4 * (m - 4); const float t2 = t3 * m1[q + 3], t1 = t2 * m1[q + 2], t0 = t1 * m1[q + 1];
            p1[q + 3] *= t3; p1[q + 2] *= t2; p1[q + 1] *= t1; p1[q] *= t0; }
        SS *= T[m];
    }
    carry = SS;
    PK4(p0, 0, pa0); PK4(p0, 8, pa1); PK4(p1, 0, pa2); PK4(p1, 8, pa3);
}
constexpr int OFF_SBFLAG = 131072 + 8192;
struct SbHalf { const bf16_t* Qh; const bf16_t* Kh; const bf16_t* Vh; const bf16_t* Zh; bf16_t* Oh; float* ssq; int hb; };
__device__ __forceinline__ void sb_block2(const SbHalf& HA, const SbHalf& HB, char* lds) {
    int tid_ = threadIdx.x; asm volatile("" : "+v"(tid_));
    const int tid = tid_, wid = __builtin_amdgcn_readfirstlane(tid >> 6), lane = tid & 63, r32 = lane & 31, hi = lane >> 5;
    const int g = wid >> 2, w4 = wid & 3;
    const bf16_t* Qh = g ? HB.Qh : HA.Qh; const bf16_t* Kh = g ? HB.Kh : HA.Kh; const bf16_t* Vh = g ? HB.Vh : HA.Vh; const bf16_t* Zh = g ? HB.Zh : HA.Zh;
    bf16_t* Oh = g ? HB.Oh : HA.Oh; float* ssq = g ? HB.ssq : HA.ssq; const int hb = g ? HB.hb : HA.hb;
    const int NT = 2 * hb + 1, smax = 2 * (HA.hb > HB.hb ? HA.hb : HB.hb) + 1;
    const int qlo = 128 * hb - 112 + w4 * QBLK, qm = qlo + r32 - 4 * hi - 1;
    char* lg = lds + g * 65536;
    f32x16 o[4] = {}; float carry = 1.f; const bool hi0 = hi == 0;
    const int vb0 = (int)(uintptr_t)lg + v_rd_base(lane);
    int gk[4], gv[4];
#pragma unroll
    for (int i = 0; i < 4; ++i) { const int o_ = 1024 * (4 * w4 + i) + 16 * lane;
      { const int row = o_ >> 8, cb = (o_ & 255) ^ ((row & 15) << 4); gk[i] = row * LDK + (cb >> 1); }
      { const int sub = o_ >> 9, w_ = o_ & 511, kk = (sub >> 2) * 8 + (w_ >> 6), c = (sub & 3) * 32 + ((w_ & 63) >> 1), k = (kk & ~0xC) | ((kk & 4) << 1) | ((kk & 8) >> 1); gv[i] = k * LDV + c; } }
    ATT_LAS char* ldsl = (ATT_LAS char*)lg;
#define DMA16(gp, lo) __builtin_amdgcn_global_load_lds((const unsigned*)(gp), (ATT_LAS unsigned*)(ldsl + (lo)), 16, 0, 0)
#define SDMA(t, bf) do { const long k0_ = (long)(t) * KVBLK; _Pragma("unroll") for (int i_ = 0; i_ < 4; ++i_) { \
        DMA16(Vh + k0_ * LDV + gv[i_], OFF_V + (bf) * SHM_V + 4096 * w4 + 1024 * i_); DMA16(Kh + k0_ * LDK + gk[i_], OFF_KN + (bf) * SHM_KN + 4096 * w4 + 1024 * i_); } } while (0)
    SDMA(NT - 1, 0);
    bf16x8 qr[8];
    { int qrow = qlo + r32; qrow = qrow < 0 ? 0 : qrow; const bf16_t* qp = Qh + (long)qrow * LDQS + hi * 8;
#pragma unroll
      for (int d0 = 0; d0 < 8; ++d0) qr[d0] = *(const bf16x8*)(qp + d0 * 16); }
    VMW();
    __syncthreads();
    f32x16 p0, p1; bf16x8 pa0, pa1, pa2, pa3;
    int* flags = (int*)(lds + OFF_SBFLAG); bool wdone = false, stop = false; const bool rowneg = qlo + r32 < 0;
#define SB_STEP(s, BUF) do { const int t_ = NT - 1 - (s); const int kb_ = t_ * KVBLK;     \
        if (t_ > 0) { SDMA(t_ - 1, (BUF) ^ 1); SBAR(); }                                                    \
        if (!wdone && t_ >= 0 && kb_ <= qlo + 30) {                                                         \
            qkt<BUF, false, 8>(p0, p1, lg, r32, hi, qr);                                                  \
            sb_elem(p0, p1, carry, kb_ + KVBLK - 1 >= qlo, qm - kb_, hi0, pa0, pa1, pa2, pa3); SBAR();    \
            pv_tile<BUF>(o, vb0, pa0, pa1, pa2, pa3);                                                     \
            wdone = __all(carry == 0.f || rowneg); }                                                      \
        if (lane == 0) flags[(BUF) * 8 + wid] = (wdone || t_ <= 0) ? 1 : 0;                                 \
        VMW();                                                                                              \
        __syncthreads();                                                                                    \
        { const int* f_ = flags + (BUF) * 8; const int a_ = f_[0] & f_[1] & f_[2] & f_[3] & f_[4] & f_[5] & f_[6] & f_[7];   \
          stop = __builtin_amdgcn_readfirstlane(a_) != 0; } } while (0)
    for (int s_ = 0; s_ < smax && !stop; s_ += 2) { SB_STEP(s_, 0); if (!stop && s_ + 1 < smax) SB_STEP(s_ + 1, 1); }
    u32x4 zz[8]; load_z(zz, Zh + (long)qlo * LDO, qlo, lane);
    float one[16];
#pragma unroll
    for (int r = 0; r < 16; ++r) one[r] = 1.f;
    store_o(o, one, Oh + (long)qlo * LDO, zz, ssq + (long)qlo * 32, qlo, r32, hi, lds + wid * 8192);
    __syncthreads();
#undef SB_STEP
#undef SDMA
#undef DMA16
}
#undef VMW
#undef PK4
#undef SBAR
#undef KSWZ
#undef KRSWZ
#undef ATT_LAS
}

constexpr int NWAVES = 8;
#ifndef MK_MULTI
#define MK_MULTI 0
#endif
constexpr int BATCH = 4, SEQ = 4096, DM = 4096, DEPTH = 4, NMETA = 16, SEQL = SEQ + NMETA;
constexpr int M = BATCH * SEQL;
constexpr int MP = 16640;
constexpr int QL = 1024, KVL = 512, NIN = 12032  , DIN = 11840, NUQ = 3072, NUKV = 4096;
constexpr float EPS = 1e-6f;
constexpr size_t MiB = 1u << 20;
constexpr size_t al2(size_t x) { return (x + 2 * MiB - 1) / (2 * MiB) * (2 * MiB); }
constexpr size_t WS_CTL = 0, CTL_ZERO_BYTES = 32768;
constexpr size_t WS_ROPE = 2 * MiB;
constexpr size_t WS_WIN = 4 * MiB;
constexpr size_t WS_WUQ = WS_WIN + al2((size_t)DEPTH * NIN * DM * 2);
constexpr size_t WS_WUKV = WS_WUQ + al2((size_t)DEPTH * NUQ * QL * 2);
constexpr size_t WS_WO = WS_WUKV + al2((size_t)DEPTH * NUKV * KVL * 2);
constexpr size_t WS_SSQ = WS_WO + al2((size_t)DEPTH * DM * DM * 2);
constexpr size_t WS_RSTD = WS_SSQ + al2((size_t)MP * 64 * 4);
constexpr size_t WS_U = WS_RSTD + al2((size_t)MP * 4);
constexpr size_t WS_SSQQ = WS_U + al2((size_t)MP * DM * 2);
constexpr size_t WS_SSQKV = WS_SSQQ + al2((size_t)MP * 16 * 4);
constexpr size_t WS_CQN = WS_SSQKV + al2((size_t)MP * 8 * 4);
constexpr size_t WS_CKVN = WS_CQN + al2((size_t)MP * QL * 2);
constexpr size_t WS_KR = WS_CKVN + al2((size_t)MP * KVL * 2);
constexpr size_t WS_Z = WS_KR + al2((size_t)MP * 64 * 2);
constexpr size_t WS_QSB = WS_Z + al2((size_t)MP * 4096 * 2);
constexpr size_t WS_KSB = WS_QSB + al2((size_t)MP * 2048 * 2);
constexpr size_t WS_VSB = WS_KSB + al2((size_t)MP * 2048 * 2);
constexpr size_t WS_QM = WS_VSB + al2((size_t)MP * 2048 * 2);
constexpr size_t WS_KM = WS_QM + al2((size_t)MP * 3072 * 2);
constexpr size_t WS_VM = WS_KM + al2((size_t)MP * 2048 * 2);
constexpr size_t WS_Y = WS_VM + al2((size_t)MP * 2048 * 2);
constexpr size_t WS_A = WS_Y + al2((size_t)MP * 4096 * 2);
constexpr size_t WS_SLAB = WS_A + al2((size_t)MP * 4096 * 2);
constexpr size_t WS_SSQY = WS_SLAB + al2((size_t)16 * 64 * 4096 * 4);
constexpr size_t WS_RATIO = WS_SSQY + al2((size_t)MP * 32 * 4);
constexpr size_t WS_RSB = WS_RATIO + al2((size_t)MP * 4);
constexpr size_t WS_END = WS_RSB + al2((size_t)MP * 4);
constexpr int MFULL = 16384;
constexpr int CW_BAR = 4096;
constexpr int RING_OFF = 0, RING_BYTES = 131072;
constexpr int LDSCTL_OFF = RING_BYTES, MISC_OFF = LDSCTL_OFF + 320;
constexpr int LDS_BYTES = 147456;
static_assert(att::ATT_LDS <= RING_BYTES && att::OFF_SBFLAG + 256 <= LDS_BYTES && att::OFF_SBFLAG >= LDSCTL_OFF + 4096, "attention LDS");

#define GAS __attribute__((address_space(1)))
#define LAS __attribute__((address_space(3)))
typedef unsigned short bf16;
typedef unsigned v4u __attribute__((ext_vector_type(4)));
typedef unsigned v2u __attribute__((ext_vector_type(2)));
typedef float f32x4 __attribute__((ext_vector_type(4)));
typedef GAS unsigned gu32;
#define RLX_AGENT __ATOMIC_RELAXED, __HIP_MEMORY_SCOPE_AGENT
#define LDS_WAIT() asm volatile("s_waitcnt lgkmcnt(0)" ::: "memory")
__device__ __forceinline__ unsigned f2bf(float f) { unsigned u = __builtin_bit_cast(unsigned, f); return (u + 0x7fffu + ((u >> 16) & 1u)) >> 16; }
__device__ __forceinline__ unsigned pk2(float lo, float hi) { return f2bf(lo) | (f2bf(hi) << 16); }
__device__ __forceinline__ float bflo(unsigned w) { return __builtin_bit_cast(float, w << 16); }
__device__ __forceinline__ float bfhi(unsigned w) { return __builtin_bit_cast(float, w & 0xffff0000u); }
#define XB_TMO      128
#define XB_XCNT(j)  (256  + 64 * (j))
#define XB_XSUB(j)  (1280 + 64 * (j))
#define XB_XGEN(j)  (2304 + 64 * (j))
#define XB_TOP      3328
#define XB_TOPGEN   3392
#define XCD_BAR_WORDS 3456
#define XB_SPIN_CAP (1u << 18)

__device__ __forceinline__ unsigned xb_ld(unsigned* p)              { return __hip_atomic_load(p, __ATOMIC_RELAXED, __HIP_MEMORY_SCOPE_AGENT); }
__device__ __forceinline__ unsigned xb_add(unsigned* p, unsigned v) { return __hip_atomic_fetch_add(p, v, __ATOMIC_RELAXED, __HIP_MEMORY_SCOPE_AGENT); }
__device__ __forceinline__ unsigned xb_xcc_id() { return (unsigned)__builtin_amdgcn_s_getreg((3 << 11) | 20) & 0xFu; }
#define XB_SPIN(cond, bar) do { unsigned _sp = 0; while (cond) { __builtin_amdgcn_s_sleep(1); \
    if ((++_sp & 255u) == 0u) { if (xb_ld(&(bar)[XB_TMO])) break; if (_sp > XB_SPIN_CAP) { atomicAdd(&(bar)[XB_TMO], 1u); break; } } } } while (0)

struct XcdBarrier {
    unsigned* bar; unsigned x;
    volatile LAS unsigned* st;
};

__device__ __forceinline__ XcdBarrier xcd_barrier_post(unsigned* bar, volatile LAS unsigned* st) {
    XcdBarrier b; b.bar = bar; b.x = xb_xcc_id(); b.st = st;
    if (threadIdx.x == 0) (void)xb_add(&bar[XB_XCNT(b.x)], 1u);
    return b;
}
__device__ __forceinline__ void xcd_barrier_complete(unsigned* bar, unsigned x, unsigned& nloc, unsigned& nx) {
    const unsigned G = gridDim.x * gridDim.y * gridDim.z;
    unsigned sum, cnt, mine, sp = 0u;
    for (;;) {
        sum = 0u; cnt = 0u; mine = 0u;
#pragma unroll
        for (unsigned j = 0; j < 16; ++j) { const unsigned c = xb_ld(&bar[XB_XCNT(j)]); sum += c; cnt += (c > 0u) ? 1u : 0u; mine = (j == x) ? c : mine; }
        if (sum == G) break;
        __builtin_amdgcn_s_sleep(1);
        if ((++sp & 255u) == 0u) { if (xb_ld(&bar[XB_TMO])) break; if (sp > XB_SPIN_CAP) { atomicAdd(&bar[XB_TMO], 1u); break; } }
    }
    nloc = mine > 0u ? mine : 1u; nx = cnt > 0u ? cnt : 1u;
}

__device__ __forceinline__ void xcd_barrier(const XcdBarrier& b) {
    asm volatile("s_waitcnt vmcnt(0)" ::: "memory");
    __syncthreads();
    if (threadIdx.x == 0) {
        unsigned* bar = b.bar;
        __builtin_amdgcn_s_waitcnt(0);
        unsigned nloc = b.st[0], nx = b.st[1];
        if (nloc == 0u) { xcd_barrier_complete(bar, b.x, nloc, nx); b.st[0] = nloc; b.st[1] = nx; }
        const unsigned old = xb_add(&bar[XB_XSUB(b.x)], 1u);
        const unsigned gen = old / nloc;
        if (old + 1u == (gen + 1u) * nloc) {
            __builtin_amdgcn_fence(__ATOMIC_RELEASE, "agent");
            asm volatile("s_waitcnt vmcnt(0)" ::: "memory");
            const unsigned og = xb_add(&bar[XB_TOP], 1u);
            const unsigned tg = og / nx;
            if (og + 1u == (tg + 1u) * nx) xb_add(&bar[XB_TOPGEN], 1u);
            else XB_SPIN(xb_ld(&bar[XB_TOPGEN]) == tg, bar);
            __builtin_amdgcn_fence(__ATOMIC_ACQUIRE, "agent");
            xb_add(&bar[XB_XGEN(b.x)], 1u);
            asm volatile("s_waitcnt vmcnt(0)" ::: "memory");
        } else {
            XB_SPIN(xb_ld(&bar[XB_XGEN(b.x)]) == gen, bar);
            __builtin_amdgcn_fence(__ATOMIC_ACQUIRE, "agent");
            asm volatile("s_waitcnt vmcnt(0)" ::: "memory");
        }
    }
    __syncthreads();
}

struct Frame {
    LAS unsigned char* lds;
    volatile LAS unsigned* MISC;
    gu32* ctl;
    int tid, lane, wave, vcu, G;
};
__device__ __forceinline__ float wave_sum(float v) {
#pragma unroll
    for (int o = 1; o < 64; o <<= 1) v += __shfl_xor(v, o);
    return v;
}
__device__ __forceinline__ void transpose_item(const float* W, int N, int K, bf16* WT, int src_col0, int dst_row0, int k0, LAS float* scr, int lane, const float* gk) {
    float tv[32];
#pragma unroll
    for (int i = 0; i < 32; ++i) { const int kk = 2 * i + (lane >> 5); tv[i] = W[(size_t)(k0 + kk) * N + src_col0 + (lane & 31)]; }
#pragma unroll
    for (int i = 0; i < 32; ++i) { const int kk = 2 * i + (lane >> 5); scr[kk * 33 + (lane & 31)] = gk ? tv[i] * gk[k0 + kk] : tv[i]; }
    LDS_WAIT(); asm volatile("" ::: "memory");
    const int c = lane & 7;
#pragma unroll
    for (int j = 0; j < 4; ++j) { const int n = (lane >> 3) + 8 * j; const LAS float* s = scr + (8 * c) * 33 + n;
        v4u o; o.x = pk2(s[0 * 33], s[1 * 33]); o.y = pk2(s[2 * 33], s[3 * 33]); o.z = pk2(s[4 * 33], s[5 * 33]); o.w = pk2(s[6 * 33], s[7 * 33]);
        *(GAS v4u*)(WT + (size_t)(dst_row0 + n) * K + k0 + 8 * c) = o; }
    LDS_WAIT(); asm volatile("" ::: "memory");
}
template <int MODE>
__device__ __forceinline__ void h_row(const float* src, bf16* HB, int row, bool tail, const float* slab, float* RSTD, const float* g, float* out, int lane) {
    f32x4 v[8][2];
    if (MODE == 0) { const GAS f32x4* sr = (const GAS f32x4*)src + 2 * lane;
#pragma unroll
        for (int j = 0; j < 8; ++j) { v[j][0] = sr[128 * j]; v[j][1] = sr[128 * j + 1]; } }
    else { const GAS v4u* hr = (const GAS v4u*)(HB + (size_t)row * DM) + lane;
#pragma unroll
        for (int j = 0; j < 8; ++j) { const v4u h = hr[64 * j]; v[j][0] = (f32x4){bflo(h.x), bfhi(h.x), bflo(h.y), bfhi(h.y)}; v[j][1] = (f32x4){bflo(h.z), bfhi(h.z), bflo(h.w), bfhi(h.w)}; }
        if (tail) for (int s = 0; s < 16; ++s) { const GAS f32x4* pr = (const GAS f32x4*)(slab + ((size_t)s * 64 + (row - MFULL)) * DM) + 2 * lane;
#pragma unroll
            for (int j = 0; j < 8; ++j) { v[j][0] += pr[128 * j]; v[j][1] += pr[128 * j + 1]; } } }
    float ss = 0.f;
    if (MODE != 2) {
        GAS v4u* hw = (GAS v4u*)(HB + (size_t)row * DM) + lane;
#pragma unroll
        for (int j = 0; j < 8; ++j) { v4u w; w.x = pk2(v[j][0].x, v[j][0].y); w.y = pk2(v[j][0].z, v[j][0].w); w.z = pk2(v[j][1].x, v[j][1].y); w.w = pk2(v[j][1].z, v[j][1].w);
            if (MODE == 0 || tail) hw[64 * j] = w;
#pragma unroll
            for (int e = 0; e < 4; ++e) { const float a = bflo(w[e]), b = bfhi(w[e]); ss += a * a + b * b; } }
        const float rstd = 1.0f / sqrtf(wave_sum(ss) * (1.0f / DM) + EPS);
        if (lane == 0) RSTD[row] = rstd;
    } else {
#pragma unroll
        for (int j = 0; j < 8; ++j) ss += (v[j][0].x * v[j][0].x + v[j][0].y * v[j][0].y) + (v[j][0].z * v[j][0].z + v[j][0].w * v[j][0].w) + (v[j][1].x * v[j][1].x + v[j][1].y * v[j][1].y) + (v[j][1].z * v[j][1].z + v[j][1].w * v[j][1].w);
        const float rstd = 1.0f / sqrtf(wave_sum(ss) * (1.0f / DM) + EPS);
        const int b = row / SEQL, t = row % SEQL;
        GAS f32x4* orow = (GAS f32x4*)(out + ((size_t)b * SEQ + (t - NMETA)) * DM) + 2 * lane; const GAS f32x4* gr = (const GAS f32x4*)g + 2 * lane;
#pragma unroll
        for (int j = 0; j < 8; ++j) { orow[128 * j] = (v[j][0] * rstd) * gr[128 * j]; orow[128 * j + 1] = (v[j][1] * rstd) * gr[128 * j + 1]; }
    }
}
template <int MODE>
__device__ __forceinline__ void h_rows(Frame& F, const float* x, const float* meta, bf16* HB, const float* slab, const float* SSQ, float* RSTD, const float* g, float* out) {
    const int gw = F.vcu * NWAVES + F.wave, NGW = F.G * NWAVES; int lane = F.lane; asm volatile("" : "+v"(lane));
    if (MODE == 0) {
        for (int row = gw; row < MP; row += NGW) {
            if (row >= M) { GAS v4u* hw = (GAS v4u*)(HB + (size_t)row * DM) + lane;
#pragma unroll
                for (int j = 0; j < 8; ++j) hw[64 * j] = (v4u){0u, 0u, 0u, 0u};
                if (lane == 0) RSTD[row] = 0.f;
                continue; }
            const int b = row / SEQL, t = row % SEQL;
            h_row<0>(t < NMETA ? meta + (size_t)t * DM : x + ((size_t)b * SEQ + (t - NMETA)) * DM, HB, row, false, nullptr, RSTD, nullptr, nullptr, lane);
        }
    } else {
        for (int i4 = F.vcu; i4 < (M - MFULL) * 4; i4 += F.G) if ((i4 & 3) == 0) {
            const int row = MFULL + (i4 >> 2), col = 512 * F.wave + 8 * lane;
            const v4u hv = *(const GAS v4u*)(HB + (size_t)row * DM + col);
            f32x4 a0 = (f32x4){bflo(hv.x), bfhi(hv.x), bflo(hv.y), bfhi(hv.y)}, a1 = (f32x4){bflo(hv.z), bfhi(hv.z), bflo(hv.w), bfhi(hv.w)};
            f32x4 s0[16], s1[16];
#pragma unroll
            for (int s = 0; s < 16; ++s) { const GAS f32x4* pr = (const GAS f32x4*)(slab + ((size_t)s * 64 + (row - MFULL)) * DM + col); s0[s] = pr[0]; s1[s] = pr[1]; }
#pragma unroll
            for (int s = 0; s < 16; ++s) { a0 += s0[s]; a1 += s1[s]; }
            float ss;
            if (MODE == 1) { v4u w; w.x = pk2(a0.x, a0.y); w.y = pk2(a0.z, a0.w); w.z = pk2(a1.x, a1.y); w.w = pk2(a1.z, a1.w);
                *(GAS v4u*)(HB + (size_t)row * DM + col) = w; ss = 0.f;
#pragma unroll
                for (int e = 0; e < 4; ++e) { const float p = bflo(w[e]), q = bfhi(w[e]); ss += p * p + q * q; } }
            else ss = (a0.x * a0.x + a0.y * a0.y) + (a0.z * a0.z + a0.w * a0.w) + (a1.x * a1.x + a1.y * a1.y) + (a1.z * a1.z + a1.w * a1.w);
            ss = wave_sum(ss);
            LAS float* red = (LAS float*)(F.lds + RING_OFF);
            if (lane == 0) red[F.wave] = ss;
            __syncthreads();
            float tot = 0.f;
#pragma unroll
            for (int w = 0; w < NWAVES; ++w) tot += red[w];
            const float rstd = 1.0f / sqrtf(tot * (1.0f / DM) + EPS);
            if (MODE == 1) { if (F.wave == 0 && lane == 0) RSTD[row] = rstd; }
            else { const int b = row / SEQL, t = row % SEQL; GAS f32x4* orow = (GAS f32x4*)(out + ((size_t)b * SEQ + (t - NMETA)) * DM + col); const GAS f32x4* gr = (const GAS f32x4*)(g + col);
                orow[0] = (a0 * rstd) * gr[0]; orow[1] = (a1 * rstd) * gr[1]; }
            __syncthreads();
        }
        if (MODE == 1) {
            for (int r4 = gw * 4; r4 < MFULL; r4 += NGW * 4) { const int row = r4 + (lane >> 4);
                const f32x4 v = *(const GAS f32x4*)(SSQ + (size_t)row * 64 + (lane & 15) * 4); float s = (v.x + v.y) + (v.z + v.w);
                s += __shfl_xor(s, 1); s += __shfl_xor(s, 2); s += __shfl_xor(s, 4); s += __shfl_xor(s, 8);
                if ((lane & 15) == 0) RSTD[row] = 1.0f / sqrtf(s * (1.0f / DM) + EPS); }
        } else {
            for (int row = gw; row < MFULL; row += NGW) { if (row % SEQL < NMETA) continue; h_row<2>(nullptr, HB, row, false, slab, RSTD, g, out, lane); }
        }
    }
}
__device__ __forceinline__ void p0_prologue(Frame& F, const float* const* in, unsigned char* ws) {
    LAS float* scr = (LAS float*)(F.lds + RING_OFF + F.wave * 16384);
    const int gw = F.vcu * NWAVES + F.wave, NGW = F.G * NWAVES;
    const float *w_in = in[3], *w_uq = in[6], *w_ukv = in[7], *w_o = in[10];
    bf16* Win_t = (bf16*)(ws + WS_WIN); bf16* Wuq_t = (bf16*)(ws + WS_WUQ); bf16* Wukv_t = (bf16*)(ws + WS_WUKV); bf16* Wo_t = (bf16*)(ws + WS_WO);
    constexpr int C_IN = 64 * 370, C_UQ = 16 * 96, C_UKV = 8 * 128, C_WO = 64 * 128, C_L = C_IN + C_UQ + C_UKV + C_WO;
    for (int it = gw; it < DEPTH * C_L; it += NGW) {
        const int l = it / C_L; int r = it % C_L;
        if (r < C_IN) { const int kb = r / 370, sb = r % 370, src = 32 * sb; const int dst = src < 1536 ? src : (src == 1536 ? 1536 : (src == 1568 ? 1664 : src + 192));
            transpose_item(w_in + (size_t)l * DM * DIN, DIN, DM, Win_t + (size_t)l * NIN * DM, src, dst, 64 * kb, scr, F.lane, in[2] + (size_t)l * DM); continue; }
        r -= C_IN;
        if (r < C_UQ) { const int kb = r / 96, sb = r % 96, hd = sb / 6, jb = sb % 6; const int dst = jb < 4 ? hd * 128 + jb * 32 : (8 + hd / 4) * 256 + (jb - 4) * 128 + (hd % 4) * 32;
            transpose_item(w_uq + (size_t)l * QL * NUQ, NUQ, QL, Wuq_t + (size_t)l * NUQ * QL, 32 * sb, dst, 64 * kb, scr, F.lane, in[4] + (size_t)l * QL); continue; }
        r -= C_UQ;
        if (r < C_UKV) { const int kb = r / 128, sb = r % 128, hd = sb / 8, jb = sb % 8; const int dst = jb < 4 ? hd * 128 + jb * 32 : 2048 + hd * 128 + (jb - 4) * 32;
            transpose_item(w_ukv + (size_t)l * KVL * NUKV, NUKV, KVL, Wukv_t + (size_t)l * NUKV * KVL, 32 * sb, dst, 64 * kb, scr, F.lane, in[5] + (size_t)l * KVL); continue; }
        r -= C_UKV;
        { const int kb = r / 128, sb = r % 128; transpose_item(w_o + (size_t)l * DM * DM, DM, DM, Wo_t + (size_t)l * DM * DM, 32 * sb, 32 * sb, 64 * kb, scr, F.lane, kb < 32 ? in[8] + (size_t)l * 2048 : in[9] + (size_t)l * 2048 - 2048); }
    }
    const int gtid = F.vcu * (NWAVES * 64) + F.tid, NT = F.G * NWAVES * 64;
    for (int idx = gtid; idx < DEPTH * 192 * 512; idx += NT) {
        const int l = idx / (192 * 512), r = idx % (192 * 512), row = r / 512, c16 = r % 512, drow = row < 96 ? 1568 + row : 1696 + (row - 96);
        *(GAS v4u*)(Win_t + ((size_t)l * NIN + drow) * DM + c16 * 8) = (v4u){0u, 0u, 0u, 0u}; }
    for (int idx = gtid; idx < (MP - M) * 512; idx += NT) *(GAS v4u*)((bf16*)(ws + WS_A) + (size_t)M * 4096 + (size_t)idx * 8) = (v4u){0u, 0u, 0u, 0u};
    float* rope = (float*)(ws + WS_ROPE);
    for (int idx = gtid; idx < SEQL * 32; idx += NT) { const int pos = idx >> 5, i = idx & 31;
        const float inv = powf(10000.0f, -(float)(2 * i) / 64.0f), ang = (float)pos * inv;
        rope[pos * 64 + i] = cosf(ang); rope[pos * 64 + 32 + i] = sinf(ang); }
    h_rows<0>(F, in[0], in[1], (bf16*)(ws + WS_U), nullptr, nullptr, (float*)(ws + WS_RSTD), nullptr, nullptr);
}

struct Args { const float* in[12]; float* out; unsigned char* ws; int ph_lo, ph_hi; };
constexpr int NPH = 1 + 7 * DEPTH;
__global__ void __launch_bounds__(NWAVES * 64, 2) hymba_fwd(Args args) {
    extern __shared__ __attribute__((aligned(16))) unsigned char lds[];
    Frame F;
    F.lds = (LAS unsigned char*)lds;
    F.MISC = (volatile LAS unsigned*)(F.lds + MISC_OFF);
    F.tid = threadIdx.x; F.lane = F.tid & 63; F.wave = __builtin_amdgcn_readfirstlane(F.tid >> 6);
    F.G = gridDim.x; { const int bx = blockIdx.x; F.vcu = (F.G % 8 == 0) ? (bx % 8) * (F.G / 8) + bx / 8 : bx; }
    unsigned char* ws = args.ws;
    F.ctl = (gu32*)(ws + WS_CTL);
    for (int u = F.tid; u < (LDS_BYTES - LDSCTL_OFF) / 4; u += NWAVES * 64) ((LAS unsigned*)(F.lds + LDSCTL_OFF))[u] = 0u;
    __syncthreads();
    XcdBarrier bar; bar.bar = (unsigned*)(F.ctl + CW_BAR); bar.x = 0; bar.st = nullptr;
    if (!MK_MULTI) bar = xcd_barrier_post((unsigned*)(F.ctl + CW_BAR), F.MISC + 8);
    const int lo = args.ph_lo, hi = args.ph_hi;
#ifndef PHMASK
#define PHMASK 0x1ff
#endif
#define EN(t) (((PHMASK) >> (t)) & 1)
#define IN(k) (lo <= (k) && (k) < hi)
#ifndef REP_BAR
#define REP_BAR 1
#endif
#define GRID_BAR(k) do { if (IN((k) + 1)) { if (!MK_MULTI) for (int rb_ = 0; rb_ < REP_BAR; ++rb_) xcd_barrier(bar); } } while (0)
#define WSL_() GAS unsigned char* wsl = (GAS unsigned char*)ws; asm volatile("" : "+s"(wsl))
#define U ((bf16*)(wsl + WS_U))
#define SSQ ((float*)(wsl + WS_SSQ))
#define RSTD ((float*)(wsl + WS_RSTD))
#define SSQY ((float*)(wsl + WS_SSQY))
#define RATIO ((float*)(wsl + WS_RATIO))
#define RSB ((float*)(wsl + WS_RSB))
#define SSQQ ((float*)(wsl + WS_SSQQ))
#define SSQKV ((float*)(wsl + WS_SSQKV))
#define CQN ((bf16*)(wsl + WS_CQN))
#define CKVN ((bf16*)(wsl + WS_CKVN))
#define KR ((bf16*)(wsl + WS_KR))
#define Zb ((bf16*)(wsl + WS_Z))
#define QSB ((bf16*)(wsl + WS_QSB))
#define KSB ((bf16*)(wsl + WS_KSB))
#define VSB ((bf16*)(wsl + WS_VSB))
#define QM ((bf16*)(wsl + WS_QM))
#define KM ((bf16*)(wsl + WS_KM))
#define VM ((bf16*)(wsl + WS_VM))
#define A ((bf16*)(wsl + WS_A))
#define rope ((const float*)(wsl + WS_ROPE))

    #ifndef REP_THIN
#define REP_THIN 1
#endif
    if (EN(0) && IN(0)) { for (int rep = 0; rep < REP_THIN; ++rep) p0_prologue(F, args.in, ws); GRID_BAR(0); }
    for (int l = 0; l < DEPTH; ++l) {
        const int pb = 1 + 7 * l;
        if (EN(1) && IN(pb)) {
            WSL_();
            pg8::Gemm g{U, (const bf16*)(wsl + WS_WIN) + (size_t)l * NIN * DM, MP, NIN, DM}; pg8::InAOrder S{F.G, (int)blockIdx.x};
            pg8::EpiIn E{CQN, CKVN, SSQQ, SSQKV, KR, Zb, QSB, KSB, VSB, rope, RSTD};
            pg8::gemm_phase<pg8::EpiIn, pg8::InAOrder, true, true>(F.lds + RING_OFF, g, S, E);
            GRID_BAR(pb);
        }
        if (EN(3) && IN(pb + 2)) {
            WSL_();
            { pg8::Gemm g{U, (const bf16*)(wsl + WS_WIN) + (size_t)l * NIN * DM, MP, NIN, DM}; pg8::InBOrder S{F.G, (int)blockIdx.x};
              pg8::EpiIn E{CQN, CKVN, SSQQ, SSQKV, KR, Zb, QSB, KSB, VSB, rope, RSTD};
              pg8::gemm_phase<pg8::EpiIn, pg8::InBOrder, true, true>(F.lds + RING_OFF, g, S, E); }
            { pg8::Gemm g{CQN, (const bf16*)(wsl + WS_WUQ) + (size_t)l * NUQ * QL, MP, NUQ, QL}; pg8::StaticOrder S; S.init(MP, NUQ, F.G, (int)(F.G - 1 - blockIdx.x));
              pg8::EpiUq E{QM, rope, SSQQ};
              pg8::gemm_phase<pg8::EpiUq, pg8::StaticOrder, true, true>(F.lds + RING_OFF, g, S, E); }
            { pg8::Gemm g{CKVN, (const bf16*)(wsl + WS_WUKV) + (size_t)l * NUKV * KVL, MP, NUKV, KVL};
              pg8::DynOrder S{(GAS unsigned*)(wsl + WS_CTL) + 64 + 16 * l, (volatile LAS unsigned*)(F.lds + LDSCTL_OFF + 4096), MP / 256, NUKV / 256, (MP / 256) * (NUKV / 256), 2, F.G, (int)blockIdx.x};
              pg8::EpiUkv E{KM, VM, SSQKV};
              pg8::gemm_phase<pg8::EpiUkv, pg8::DynOrder, true, true>(F.lds + RING_OFF, g, S, E); }
            GRID_BAR(pb + 2);
        }
        if (IN(pb + 3)) {
            WSL_(); char* al = (char*)lds + RING_OFF;
            const int npair = (512 - F.vcu + F.G - 1) / F.G;
            const int m0a = F.vcu, m0b = (F.vcu + F.G - 64 % F.G) % F.G;
            const int nmeta_a = m0a < 64 ? (63 - m0a) / F.G + 1 : 0, nmeta_b = m0b < 64 ? (63 - m0b) / F.G + 1 : 0;
#ifndef REP_MLA
#define REP_MLA 1
#endif
            if (EN(4)) for (int rep = 0; rep < REP_MLA; ++rep) {
#pragma clang loop unroll(disable)
                for (int j = 0; j < 2 * npair + nmeta_a; ++j) {
                    int bh, qb;
                    if (j < 2 * npair) { const int item = F.vcu + F.G * (j >> 1), p = item & 7; bh = item >> 3; qb = (j & 1) ? 1 + p : 16 - p; }
                    else { bh = m0a + F.G * (j - 2 * npair); qb = 0; }
                    const size_t row0 = (size_t)(bh >> 4) * SEQL; const int hd = bh & 15;
                    att::mla_block(QM + row0 * 3072 + hd * 192, KM + row0 * 2048 + hd * 128, KR + row0 * 64, VM + row0 * 2048 + hd * 128, A + row0 * 4096 + hd * 128, Zb + row0 * 4096 + hd * 128, SSQY + row0 * 32 + hd, qb, al);
                }
            }
#ifndef REP_SB
#define REP_SB 1
#endif
            if (EN(5)) {
                const int dyn0 = 2 * F.G < 1024 ? 2 * F.G : 1024; int js = 0, nextdyn = 0;
                volatile LAS unsigned* slot = (volatile LAS unsigned*)(F.lds + LDSCTL_OFF + 4096 + 64);
                GAS unsigned* sbctr = (GAS unsigned*)(wsl + WS_CTL) + 2048 + 32 * l;
                int t0_ = threadIdx.x; asm volatile("" : "+v"(t0_)); const int w0_ = __builtin_amdgcn_readfirstlane(t0_ >> 6);
                if (!(F.vcu < dyn0)) {
                    if (t0_ == 0) slot[0] = __hip_atomic_fetch_add(sbctr, 1u, __ATOMIC_RELAXED, __HIP_MEMORY_SCOPE_AGENT);
                    __syncthreads(); nextdyn = __builtin_amdgcn_readfirstlane((int)slot[0]); }
#pragma clang loop unroll(disable)
                for (;;) {
                    int item;
                    if (js < 2 && F.vcu + F.G * js < dyn0) { item = F.vcu + F.G * js; ++js; }
                    else { js = 2; item = dyn0 + nextdyn; if (item >= 1024 + 32) break; }
                    const bool ndyn = !(js < 2 && F.vcu + F.G * js < dyn0);
                    unsigned pend_ = 0;
                    if (ndyn && w0_ == 0) asm volatile("s_mov_b64 exec, 1\n\tglobal_atomic_add %0, %1, %2, off sc0\n\ts_mov_b64 exec, -1" : "=v"(pend_) : "v"(sbctr), "v"(1u) : "memory");
                    const bool meta = item >= 1024; if (meta) item -= 1024;
                    const int ppq = 15 - (item >> 6);
                    const int bhA = meta ? 2 * item : item & 63, bhB = meta ? 2 * item + 1 : bhA, hbA = meta ? 0 : 2 * ppq + 1, hbB = meta ? 0 : hbA + 1;
                    const size_t rA = (size_t)(bhA >> 4) * SEQL, rB = (size_t)(bhB >> 4) * SEQL; const int hA = bhA & 15, hB = bhB & 15;
                    const att::SbHalf HA{QSB + rA * 2048 + hA * 128, KSB + rA * 2048 + hA * 128, VSB + rA * 2048 + hA * 128, Zb + rA * 4096 + 2048 + hA * 128, A + rA * 4096 + 2048 + hA * 128, SSQY + rA * 32 + 16 + hA, hbA};
                    const att::SbHalf HB{QSB + rB * 2048 + hB * 128, KSB + rB * 2048 + hB * 128, VSB + rB * 2048 + hB * 128, Zb + rB * 4096 + 2048 + hB * 128, A + rB * 4096 + 2048 + hB * 128, SSQY + rB * 32 + 16 + hB, hbB};
                    att::sb_block2(HA, HB, al);
                    if (ndyn) { if (w0_ == 0) { asm volatile("s_waitcnt vmcnt(0)" ::: "memory"); if (t0_ == 0) slot[0] = pend_; }
                        __syncthreads(); nextdyn = __builtin_amdgcn_readfirstlane((int)slot[0]); }
                }
            }
            GRID_BAR(pb + 3);
        }
        if (EN(7) && IN(pb + 5)) {
            WSL_();
            LAS float* ytab = (LAS float*)(F.lds + LDSCTL_OFF + 1024);
#define FILL_YTAB(pm_) do { int t0_ = F.tid; asm volatile("" : "+v"(t0_)); for (int r_ = t0_; r_ < 256; r_ += NWAVES * 64) { const int row_ = (pm_) * 256 + r_; float ra_ = 0.f, rb_ = 0.f;                                  \
                if (row_ < M) { const GAS f32x4* sp_ = (const GAS f32x4*)(SSQY + (size_t)row_ * 32); float s1_ = 0.f, s2_ = 0.f;                                                  \
                    _Pragma("unroll") for (int j_ = 0; j_ < 4; ++j_) { const f32x4 a_ = sp_[j_], b_ = sp_[4 + j_]; s1_ += (a_.x + a_.y) + (a_.z + a_.w); s2_ += (b_.x + b_.y) + (b_.z + b_.w); } \
                    const float r1_ = 1.0f / sqrtf(s1_ * (1.0f / 2048) + EPS), r2_ = 1.0f / sqrtf(s2_ * (1.0f / 2048) + EPS); ra_ = r1_ / r2_; rb_ = r2_; }                     \
                ytab[r_] = ra_; ytab[256 + r_] = rb_; } __syncthreads(); } while (0)
            { pg8::Gemm g{A, (const bf16*)(wsl + WS_WO) + (size_t)l * DM * DM, 16384, DM, DM, DM}; pg8::StaticOrder S; S.init(16384, DM, F.G, (int)blockIdx.x);
              { pg8::Unit u0; if (S.next(0, u0)) FILL_YTAB(u0.pm); else __syncthreads(); }
              pg8::EpiResBf E{U, SSQ, (const LAS float*)ytab};
              pg8::gemm_phase<pg8::EpiResBf, pg8::StaticOrder, true, true>(F.lds + RING_OFF, g, S, E); }
#if defined(REP_OUT)
#endif
            { pg8::Gemm g{A, (const bf16*)(wsl + WS_WO) + (size_t)l * DM * DM, MP, DM, 256, DM}; pg8::SplitKOrder S{64, 16, 16, 256, F.G, (int)blockIdx.x};
              FILL_YTAB(64);
              pg8::EpiSlab E{(float*)(wsl + WS_SLAB), 256, (const LAS float*)ytab};
              pg8::gemm_phase<pg8::EpiSlab, pg8::SplitKOrder, true, true>(F.lds + RING_OFF, g, S, E); }
#undef FILL_YTAB
            GRID_BAR(pb + 5);
        }
        if (EN(8) && IN(pb + 6)) {
            WSL_();
            if (l + 1 < DEPTH) { h_rows<1>(F, nullptr, nullptr, U, (const float*)(wsl + WS_SLAB), SSQ, RSTD, nullptr, nullptr); GRID_BAR(pb + 6); }
            else h_rows<2>(F, nullptr, nullptr, U, (const float*)(wsl + WS_SLAB), SSQ, RSTD, args.in[11], args.out);
        }
    }
#undef IN
#undef GRID_BAR
#undef WSL_
#undef U
#undef SSQ
#undef RSTD
#undef SSQY
#undef RATIO
#undef RSB
#undef SSQQ
#undef SSQKV
#undef CQN
#undef CKVN
#undef KR
#undef Zb
#undef QSB
#undef KSB
#undef VSB
#undef QM
#undef KM
#undef VM
#undef A
#undef rope
}

extern "C" void kernel_launch(void* const* d_in, const int* in_sizes, int n_in, void* d_out, int out_size, void* d_ws, size_t ws_size, hipStream_t stream) {
    static int grid = 0;
    if (grid == 0) {
        if (n_in != 12 || in_sizes[0] != BATCH * SEQ * DM || out_size != BATCH * SEQ * DM || ws_size < WS_END) {
            fprintf(stderr, "kernel_launch: shape/workspace mismatch (n_in %d, in0 %d, out %d, ws %zu, need %zu); nothing launched\n", n_in, n_in > 0 ? in_sizes[0] : -1, out_size, ws_size, (size_t)WS_END); grid = -1; return; }
        int dev = 0, cus = 0, per_cu = 0;
        if (hipGetDevice(&dev) != hipSuccess || hipDeviceGetAttribute(&cus, hipDeviceAttributeMultiprocessorCount, dev) != hipSuccess) { grid = -1; return; }
        if (hipFuncSetAttribute((const void*)hymba_fwd, hipFuncAttributeMaxDynamicSharedMemorySize, LDS_BYTES) != hipSuccess) { fprintf(stderr, "kernel_launch: hipFuncSetAttribute failed\n"); grid = -1; return; }
        if (hipOccupancyMaxActiveBlocksPerMultiprocessor(&per_cu, (const void*)hymba_fwd, NWAVES * 64, LDS_BYTES) != hipSuccess || per_cu < 1)
            fprintf(stderr, "kernel_launch: note: occupancy query reports %d workgroups per CU\n", per_cu);
        (void)hipGetLastError();
        grid = cus;
    }
    if (grid < 0) return;
    if (hipMemsetAsync((char*)d_ws + WS_CTL, 0, CTL_ZERO_BYTES, stream) != hipSuccess) return;
    Args a{};
    for (int i = 0; i < 12; ++i) a.in[i] = (const float*)d_in[i];
    a.out = (float*)d_out; a.ws = (unsigned char*)d_ws;
#if MK_MULTI
    for (int ph = 0; ph < NPH; ++ph) { a.ph_lo = ph; a.ph_hi = ph + 1; hipLaunchKernelGGL(hymba_fwd, dim3(grid), dim3(NWAVES * 64), LDS_BYTES, stream, a); }
#else
    a.ph_lo = 0; a.ph_hi = NPH;
    hipLaunchKernelGGL(hymba_fwd, dim3(grid), dim3(NWAVES * 64), LDS_BYTES, stream, a);
#endif
    const hipError_t le = hipPeekAtLastError();
    if (le != hipSuccess) fprintf(stderr, "kernel_launch: launch failed: %s\n", hipGetErrorName(le));
}
```
